# Optimizing an MI355X kernel written in HIP

```python
import math
import jax, jax.numpy as jnp
from jax import lax
import numpy as np

D_MODEL = 1024
BATCH = 8
SEQ = 2048
DEPTH = 4

GRID_W = 64
CTX_LEN = 256
N_MIXERS = 3
N_A = (DEPTH + 2) // 3
N_B = (DEPTH + 1) // 3
N_C = DEPTH // 3

DA_HEADS = 8
DA_HEAD_DIM = D_MODEL // (2 * DA_HEADS)
Q_BLOCK = 128

RET_HEADS = 4
RET_QK_DIM = D_MODEL // RET_HEADS
RET_V_DIM = 2 * RET_QK_DIM
RET_CHUNK = 128

NA_HEADS = 16
NA_HEAD_DIM = D_MODEL // NA_HEADS
NA_KH = 8
NA_KW = 16

FFN_HIDDEN = -(-8 * D_MODEL // (3 * 256)) * 256
ROPE_BASE = 10000.0
EPS = 1e-6
F32 = jnp.float32

kernel_name = 'hybrid_diffattn_retention_natten_prefix_trunk'


def _rms(x):
    x32 = x.astype(F32)
    return x32 * lax.rsqrt(jnp.mean(x32 * x32, axis=-1, keepdims=True) + EPS)


def rms_norm(x, g):
    return (_rms(x) * g.astype(F32)).astype(x.dtype)


def modulate(x, g, shift, scale):
    return rms_norm(x, g) * (1 + scale) + shift


def ada_mod(cond, w, b):
    m = jax.nn.silu(cond) @ w + b
    return [a[:, None, :] for a in jnp.split(m, 6, axis=-1)]


def axial_rope(x, rows, cols):
    d = x.shape[-1]
    f = d // 4
    inv = ROPE_BASE ** (-jnp.arange(f, dtype=F32) / f)
    ang = jnp.concatenate([rows.astype(F32)[:, None] * inv, cols.astype(F32)[:, None] * inv], axis=-1)[:, None, :]
    cos, sin = jnp.cos(ang), jnp.sin(ang)
    x32 = x.astype(F32)
    x1, x2 = x32[..., : d // 2], x32[..., d // 2:]
    return jnp.concatenate([x1 * cos - x2 * sin, x1 * sin + x2 * cos], axis=-1).astype(x.dtype)


def swiglu(h, w_in, w_out):
    a, b = jnp.split(h @ w_in, 2, axis=-1)
    return (jax.nn.silu(a) * b) @ w_out


def _diff_core(q, k, v, lam, scale):
    s = jnp.einsum('bqnd,bknd->bnqk', q, k).astype(F32) * scale
    p = jax.nn.softmax(s, axis=-1)
    b, n, tq, tk = p.shape
    p = p.reshape(b, n // 2, 2, tq, tk)
    a = p[:, :, 0] - lam * p[:, :, 1]
    return jnp.einsum('bhqk,bkhe->bqhe', a.astype(v.dtype), v)


def diff_attention(hx, hz, w_qkv, w_o, lam_p, subln_g, lam_init, rows, cols, need_ctx):
    B, L, D = hx.shape
    H, dh = DA_HEADS, DA_HEAD_DIM

    def qkv(h):
        T = h.shape[1]
        q, k, v = jnp.split(h @ w_qkv, 3, axis=-1)
        return q.reshape(B, T, 2 * H, dh), k.reshape(B, T, 2 * H, dh), v.reshape(B, T, H, 2 * dh)

    qx, kx, vx = qkv(hx)
    qz, kz, vz = qkv(hz)
    qx = axial_rope(qx, rows, cols)
    kx = axial_rope(kx, rows, cols)
    lp = lam_p.astype(F32)
    lam = jnp.exp(jnp.sum(lp[0] * lp[1])) - jnp.exp(jnp.sum(lp[2] * lp[3])) + lam_init
    scale = dh ** -0.5
    k_all = jnp.concatenate([kx, kz], axis=1)
    v_all = jnp.concatenate([vx, vz], axis=1)
    nb = L // Q_BLOCK
    qb = jnp.moveaxis(qx.reshape(B, nb, Q_BLOCK, 2 * H, dh), 1, 0)
    ox = lax.map(lambda qi: _diff_core(qi, k_all, v_all, lam, scale), qb)
    ox = jnp.moveaxis(ox, 0, 1).reshape(B, L, H, 2 * dh)

    def finish(o):
        o = rms_norm(o, subln_g) * (1.0 - lam_init)
        return o.reshape(B, o.shape[1], H * 2 * dh) @ w_o

    out_x = finish(ox)
    out_z = finish(_diff_core(qz, kz, vz, lam, scale)) if need_ctx else None
    return out_x, out_z


def _retention_scan(q, k, v, log_g, S0, inclusive):
    B, T, H, dk = q.shape
    dv = v.shape[-1]
    C = RET_CHUNK
    n = T // C

    def chunks(a):
        return jnp.moveaxis(a.astype(F32).reshape(B, n, C, H, a.shape[-1]), 1, 0)

    idx = jnp.arange(C, dtype=F32)
    diff = idx[:, None] - idx[None, :]
    mask = (diff >= 0) if inclusive else (diff > 0)
    dmat = jnp.where(mask[None], jnp.exp(jnp.maximum(diff, 0.0)[None] * log_g[:, None, None]), 0.0)
    xi = jnp.exp((idx[:, None] + 1.0) * log_g[None, :])
    zeta = jnp.exp((C - 1.0 - idx)[:, None] * log_g[None, :])
    decay_c = jnp.exp(C * log_g)

    def step(S, inp):
        qc, kc, vc = inp
        s = jnp.einsum('bihd,bjhd->bhij', qc, kc) * dmat
        o = jnp.einsum('bhij,bjhe->bihe', s, vc) + jnp.einsum('bihd,bhde->bihe', qc, S) * xi[None, :, :, None]
        S = S * decay_c[None, :, None, None] + jnp.einsum('bjhd,bjhe->bhde', kc * zeta[None, :, :, None], vc)
        return S, o

    S, o = lax.scan(step, S0, (chunks(q), chunks(k), chunks(v)))
    return jnp.moveaxis(o, 0, 1).reshape(B, T, H, dv), S


def retention(hx, hz, w_in, w_o, decay_logit, rows, cols, need_ctx):
    B = hx.shape[0]
    H, dk, dv = RET_HEADS, RET_QK_DIM, RET_V_DIM

    def proj(h):
        T = h.shape[1]
        q, k, v, g = jnp.split(h @ w_in, [H * dk, 2 * H * dk, 2 * H * dk + H * dv], axis=-1)
        return q.reshape(B, T, H, dk), k.reshape(B, T, H, dk) * dk ** -0.5, v.reshape(B, T, H, dv), g

    qx, kx, vx, gx = proj(hx)
    qz, kz, vz, gz = proj(hz)
    qx = axial_rope(qx, rows, cols)
    kx = axial_rope(kx, rows, cols)
    log_g = jax.nn.log_sigmoid(decay_logit.astype(F32))
    S0 = jnp.zeros((B, H, dk, dv), F32)

    def flip(a):
        return a[:, ::-1]

    oz_f, Sz_f = _retention_scan(qz, kz, vz, log_g[0], S0, True)
    ox_f, _ = _retention_scan(qx, kx, vx, log_g[0], Sz_f, True)
    oz_b, Sz_b = _retention_scan(flip(qz), flip(kz), flip(vz), log_g[1], S0, False)
    ox_b, _ = _retention_scan(flip(qx), flip(kx), flip(vx), log_g[1], Sz_b, False)

    def finish(o, g):
        T = o.shape[1]
        o = _rms(o).reshape(B, T, H * dv).astype(g.dtype)
        return (jax.nn.silu(g) * o) @ w_o

    out_x = finish(ox_f + flip(ox_b), gx)
    out_z = finish(oz_f + flip(oz_b), gz) if need_ctx else None
    return out_x, out_z


def neighborhood_attention(hx, hz, w_qkv, w_o, rpb, need_ctx):
    B, L, D = hx.shape
    H, dh = NA_HEADS, NA_HEAD_DIM
    R = L // GRID_W
    W = GRID_W
    kh = min(NA_KH, R)
    kw = NA_KW
    scale = dh ** -0.5

    def qkv(h):
        T = h.shape[1]
        q, k, v = jnp.split(h @ w_qkv, 3, axis=-1)
        return q.reshape(B, T, H, dh), k.reshape(B, T, H, dh), v.reshape(B, T, H, dh)

    qx, kx, vx = qkv(hx)
    qz, kz, vz = qkv(hz)
    kg = kx.reshape(B, R, W, H, dh)
    vg = vx.reshape(B, R, W, H, dh)
    col = jnp.arange(W)
    cs = jnp.clip(col - kw // 2, 0, W - kw)
    col_ok = (col[None, :] >= cs[:, None]) & (col[None, :] < cs[:, None] + kw)
    dc_idx = jnp.clip(col[None, :] - col[:, None] + NA_KW - 1, 0, 2 * NA_KW - 2)
    rpb32 = rpb.astype(F32)

    def row_block(args):
        r, qr = args
        rs = jnp.clip(r - kh // 2, 0, R - kh)
        kb = lax.dynamic_slice_in_dim(kg, rs, kh, axis=1)
        vb = lax.dynamic_slice_in_dim(vg, rs, kh, axis=1)
        dr_idx = rs + jnp.arange(kh) - r + NA_KH - 1
        bias = rpb32[:, dr_idx[:, None, None], dc_idx[None, :, :]]
        bias = jnp.where(col_ok[None, None], bias, -jnp.inf).transpose(0, 2, 1, 3)
        s_lat = jnp.einsum('bqhd,bkwhd->bhqkw', qr, kb).astype(F32) * scale + bias
        s_ctx = jnp.einsum('bqhd,bnhd->bhqn', qr, kz).astype(F32) * scale
        s = jnp.concatenate([s_lat.reshape(B, H, W, kh * W), s_ctx], axis=-1)
        p = jax.nn.softmax(s, axis=-1).astype(vb.dtype)
        p_lat = p[..., : kh * W].reshape(B, H, W, kh, W)
        return (jnp.einsum('bhqkw,bkwhd->bqhd', p_lat, vb)
                + jnp.einsum('bhqn,bnhd->bqhd', p[..., kh * W:], vz))

    qg = jnp.moveaxis(qx.reshape(B, R, W, H, dh), 1, 0)
    ox = lax.map(row_block, (jnp.arange(R), qg))
    out_x = jnp.moveaxis(ox, 0, 1).reshape(B, L, D) @ w_o
    out_z = None
    if need_ctx:
        s = jnp.einsum('bqhd,bkhd->bhqk', qz, kz).astype(F32) * scale
        p = jax.nn.softmax(s, axis=-1).astype(vz.dtype)
        oz = jnp.einsum('bhqk,bkhd->bqhd', p, vz)
        out_z = oz.reshape(B, oz.shape[1], D) @ w_o
    return out_x, out_z


def setup_inputs(seed: int = 0) -> dict:
    key = jax.random.key(seed)
    ks = jax.random.split(key, 24)
    D = D_MODEL

    def nrm(k, shape, s):
        return jax.random.normal(k, shape, F32) * s

    gamma0 = 1.0 - 2.0 ** (-5.0 - jnp.arange(RET_HEADS, dtype=F32))
    decay_base = jnp.log(gamma0) - jnp.log1p(-gamma0)
    ret_in_w = 2 * RET_HEADS * RET_QK_DIM + 2 * RET_HEADS * RET_V_DIM
    return {
        'x': nrm(ks[0], (BATCH, SEQ, D), 1.0),
        'c': nrm(ks[1], (BATCH, D), 1.0),
        'ctx': nrm(ks[2], (BATCH, CTX_LEN, D), 1.0),
        'c_ctx': nrm(ks[3], (D,), 1.0),
        'w_ada': nrm(ks[4], (DEPTH, D, 6 * D), 0.5 * D ** -0.5),
        'b_ada': nrm(ks[5], (DEPTH, 6 * D), 0.02),
        'norm_g': 1.0 + nrm(ks[6], (DEPTH, 2, D), 0.02),
        'ffn_in': nrm(ks[7], (DEPTH, D, 2 * FFN_HIDDEN), D ** -0.5),
        'ffn_out': nrm(ks[8], (DEPTH, FFN_HIDDEN, D), FFN_HIDDEN ** -0.5),
        'final_g': 1.0 + nrm(ks[9], (D,), 0.02),
        'da_w_qkv': nrm(ks[10], (N_A, D, 3 * D), D ** -0.5),
        'da_w_o': nrm(ks[11], (N_A, D, D), D ** -0.5),
        'da_lambda': nrm(ks[12], (N_A, 4, DA_HEAD_DIM), 0.1),
        'da_subln': 1.0 + nrm(ks[13], (N_A, 2 * DA_HEAD_DIM), 0.02),
        'ret_w_in': nrm(ks[14], (N_B, D, ret_in_w), D ** -0.5),
        'ret_w_o': nrm(ks[15], (N_B, RET_HEADS * RET_V_DIM, D), (RET_HEADS * RET_V_DIM) ** -0.5),
        'ret_decay': decay_base[None, None, :] + nrm(ks[16], (N_B, 2, RET_HEADS), 0.1),
        'na_w_qkv': nrm(ks[17], (N_C, D, 3 * D), D ** -0.5),
        'na_w_o': nrm(ks[18], (N_C, D, D), D ** -0.5),
        'na_rpb': nrm(ks[19], (N_C, NA_HEADS, 2 * NA_KH - 1, 2 * NA_KW - 1), 0.02),
    }


def reference(x, c, ctx, c_ctx, w_ada, b_ada, norm_g, ffn_in, ffn_out, final_g,
              da_w_qkv, da_w_o, da_lambda, da_subln,
              ret_w_in, ret_w_o, ret_decay,
              na_w_qkv, na_w_o, na_rpb):
    B, L, D = x.shape
    t = jnp.arange(L)
    rows = t // GRID_W
    cols = t % GRID_W
    z = ctx
    cz = c_ctx[None, :]
    ia = ib = ic = 0
    for li in range(DEPTH):
        kind = li % N_MIXERS
        need_ctx = li < DEPTH - 1
        sh1, sc1, gt1, sh2, sc2, gt2 = ada_mod(c, w_ada[li], b_ada[li])
        zsh1, zsc1, zgt1, zsh2, zsc2, zgt2 = ada_mod(cz, w_ada[li], b_ada[li])
        hx = modulate(x, norm_g[li, 0], sh1, sc1)
        hz = modulate(z, norm_g[li, 0], zsh1, zsc1)
        if kind == 0:
            lam_init = 0.8 - 0.6 * math.exp(-0.3 * li)
            ox, oz = diff_attention(hx, hz, da_w_qkv[ia], da_w_o[ia], da_lambda[ia], da_subln[ia],
                                    lam_init, rows, cols, need_ctx)
            ia += 1
        elif kind == 1:
            ox, oz = retention(hx, hz, ret_w_in[ib], ret_w_o[ib], ret_decay[ib], rows, cols, need_ctx)
            ib += 1
        else:
            ox, oz = neighborhood_attention(hx, hz, na_w_qkv[ic], na_w_o[ic], na_rpb[ic], need_ctx)
            ic += 1
        x = x + gt1 * ox
        x = x + gt2 * swiglu(modulate(x, norm_g[li, 1], sh2, sc2), ffn_in[li], ffn_out[li])
        if need_ctx:
            z = z + zgt1 * oz
            z = z + zgt2 * swiglu(modulate(z, norm_g[li, 1], zsh2, zsc2), ffn_in[li], ffn_out[li])
    return rms_norm(x, final_g)
```

```cpp
#include <hip/hip_runtime.h>
#include <hip/hip_cooperative_groups.h>
#include <cstdio>
#include <cstdint>
namespace cg = cooperative_groups;
__device__ __forceinline__ int ltid() { int t = threadIdx.x; asm volatile("" : "+v"(t)); return t; }
__device__ __forceinline__ int lbid() { int t = blockIdx.x; asm volatile("" : "+s"(t)); return t; }
__device__ __forceinline__ int lgrid() { int t = gridDim.x; asm volatile("" : "+s"(t)); return t; }
namespace pg8 {
#define PG8_LAS __attribute__((address_space(3)))
typedef unsigned short bf16_t;
typedef short bf16x8 __attribute__((ext_vector_type(8)));
typedef float f32x4 __attribute__((ext_vector_type(4)));
typedef unsigned u32x4 __attribute__((ext_vector_type(4)));
constexpr int BM = 256, BK = 64, HALF = 128, HTB = HALF * BK * 2  , STAGE_BYTES = 8 * HTB, NXCD = 8, WGM = 8;

__host__ __device__ __forceinline__ int lds_byte(int r, int c) { const int st = (r >> 4) * 2 + (c >> 5), rr = r & 15, cc = c & 31, ob = rr * 64 + cc * 2; return st * 1024 + (ob ^ (((ob >> 9) & 1) << 5)); }
__host__ __device__ __forceinline__ void stage_rc(int b, int& R, int& C) { const int st = b / 1024, sb = b % 1024, swz = sb ^ (((sb >> 9) & 1) << 5); R = (st >> 1) * 16 + swz / 64; C = (st & 1) * 32 + (swz % 64) / 2; }
__host__ __device__ __forceinline__ int perm32(int rho) { const int n = rho >> 4, i = rho & 15; return 8 * (i >> 2) + 4 * n + (i & 3); }

struct Unit { int pm, pn, k0, nt, part; };
struct Gemm { const bf16_t* A; const bf16_t* Bt; int M, N, K; };

struct StaticOrder {
    int nM, nN, nwg, G, c;
    __host__ __device__ void init(int M, int N, int G_, int c_) { nM = M / BM; nN = N / BM; nwg = nM * nN; G = G_; c = c_; }
    __host__ __device__ bool next(int i, Unit& u) const {
        const long L = (long)i * G + c; if (L >= nwg) return false;
        int wgid = (int)L; { const int q = nwg / NXCD, r = nwg % NXCD, xcd = wgid % NXCD, off = wgid / NXCD; wgid = (xcd < r ? xcd * (q + 1) : r * (q + 1) + (xcd - r) * q) + off; }
        const int nig = WGM * nN, gid = wgid / nig, fm = gid * WGM, gsz = (nM - fm) < WGM ? (nM - fm) : WGM;
        u.pm = fm + ((wgid % nig) % gsz); u.pn = (wgid % nig) / gsz; return true;
    }
    __device__ __forceinline__ void a_ready(const Unit&) const {}
    __device__ __forceinline__ void done(const Unit&) const {}
};

__device__ __forceinline__ unsigned cvt_pk_bf16(float lo, float hi) { unsigned r; asm volatile("v_cvt_pk_bf16_f32 %0, %1, %2" : "=v"(r) : "v"(lo), "v"(hi)); return r; }
typedef float f32x2 __attribute__((ext_vector_type(2)));
template <class Epi, class Sched, bool ALIGN_EPI = false, bool SP2 = false>
__device__ __forceinline__ void gemm_phase(PG8_LAS unsigned char* lds, const Gemm g, const Sched& S, const Epi& E) {
    const int tid = ltid(), wid = __builtin_amdgcn_readfirstlane(tid >> 6), lane = tid & 63, wr = wid >> 2, wc = wid & 3, fr = lane & 15, fq = lane >> 4;
    const int K = g.K;
    unsigned voffA[2], voffB[2];
#pragma unroll
    for (int i = 0; i < 2; ++i) { int R, C; stage_rc(tid * 16 + i * 8192, R, C); const int Rb = Epi::PERM ? ((R & ~31) + perm32(R & 31)) : R;
        voffA[i] = (unsigned)(R * K + C) * 2u; voffB[i] = (unsigned)(Rb * K + C) * 2u; }
    const size_t kstep = (size_t)(BK * 2);
    const size_t hstep = (size_t)HALF * K * 2;
    const size_t tstep = 2 * hstep;
    const unsigned ldsw = (unsigned)wid * 1024u;
    const int aoff = lds_byte(wr * 64 + fr, fq * 8), boff = lds_byte(wc * 32 + fr, fq * 8);
#define PG8_SA(b, h) (((b) * 2 + (h)) * HTB)
#define PG8_SB(b, h) ((4 + (b) * 2 + (h)) * HTB)
#define PG8_STAGE(bufoff, gbase, voff) do { _Pragma("unroll") for (int _i = 0; _i < 2; ++_i) \
        __builtin_amdgcn_global_load_lds((const unsigned*)((const char*)(gbase) + (voff)[_i]), (PG8_LAS unsigned*)(lds + (bufoff) + ldsw + _i * 8192), 16, 0, 0); } while (0)
#define PG8_LDA(dst, b, h) do { _Pragma("unroll") for (int m = 0; m < 4; ++m) _Pragma("unroll") for (int k = 0; k < 2; ++k) dst[m][k] = *(const PG8_LAS bf16x8*)(lds + PG8_SA(b, h) + aoff + m * 2048 + k * 1024); } while (0)
#define PG8_LDB(dst, b, h) do { _Pragma("unroll") for (int n = 0; n < 2; ++n) _Pragma("unroll") for (int k = 0; k < 2; ++k) dst[n][k] = *(const PG8_LAS bf16x8*)(lds + PG8_SB(b, h) + boff + n * 2048 + k * 1024); } while (0)
#define PG8_MMA(ai, bj, At, Bt) do { __builtin_amdgcn_s_setprio(1); _Pragma("unroll") for (int m = 0; m < 4; ++m) _Pragma("unroll") for (int n = 0; n < 2; ++n) _Pragma("unroll") for (int k = 0; k < 2; ++k) \
        acc[ai][bj][m][n] = __builtin_amdgcn_mfma_f32_16x16x32_bf16(Bt[n][k], At[m][k], acc[ai][bj][m][n], 0, 0, 0); __builtin_amdgcn_s_setprio(0); } while (0)
#define PG8_WAIT_V(n) asm volatile("s_waitcnt vmcnt(" #n ")" ::: "memory")
#define PG8_WAIT_L(n) asm volatile("s_waitcnt lgkmcnt(" #n ")" ::: "memory")
#define PG8_BAR __builtin_amdgcn_s_barrier()
#define PG8_SCHED __builtin_amdgcn_sched_barrier(0)
    Unit cur, nxt; int ui = 0;
    if (!S.next(0, cur)) return;
    f32x4 acc[2][2][4][2];
#pragma unroll
    for (int a = 0; a < 2; ++a)
#pragma unroll
        for (int b = 0; b < 2; ++b)
#pragma unroll
            for (int m = 0; m < 4; ++m)
#pragma unroll
                for (int n = 0; n < 2; ++n) acc[a][b][m][n] = (f32x4){0.f, 0.f, 0.f, 0.f};
    bf16x8 At[4][2], B0[2][2], B1[2][2];
    const char* cA = (const char*)g.A + (size_t)cur.pm * tstep + (size_t)cur.k0 * 2; const char* cB = (const char*)g.Bt + (size_t)cur.pn * tstep + (size_t)cur.k0 * 2;
    S.a_ready(cur);
    if constexpr (SP2) {
        PG8_STAGE(PG8_SB(0, 0), cB, voffB); PG8_STAGE(PG8_SB(0, 1), cB + hstep, voffB); PG8_STAGE(PG8_SA(0, 0), cA, voffA); PG8_STAGE(PG8_SA(0, 1), cA + hstep, voffA);
        if (wr == 1) PG8_BAR;
        PG8_WAIT_V(2); PG8_BAR;
        PG8_STAGE(PG8_SB(1, 0), cB + kstep, voffB); PG8_STAGE(PG8_SA(1, 0), cA + kstep, voffA); PG8_STAGE(PG8_SB(1, 1), cB + hstep + kstep, voffB);
        PG8_WAIT_V(6); PG8_BAR;
    } else {
        PG8_STAGE(PG8_SB(0, 0), cB, voffB); PG8_STAGE(PG8_SA(0, 0), cA, voffA); PG8_STAGE(PG8_SB(0, 1), cB + hstep, voffB); PG8_STAGE(PG8_SA(0, 1), cA + hstep, voffA);
        if (wr == 1) PG8_BAR;
        PG8_WAIT_V(4); PG8_BAR;
        PG8_STAGE(PG8_SB(1, 0), cB + kstep, voffB); PG8_STAGE(PG8_SA(1, 0), cA + kstep, voffA); PG8_STAGE(PG8_SB(1, 1), cB + hstep + kstep, voffB);
        PG8_WAIT_V(6); PG8_BAR;
    }
    for (;;) {
        const bool has_next = S.next(ui + 1, nxt);
        const char* nA = has_next ? (const char*)g.A + (size_t)nxt.pm * tstep + (size_t)nxt.k0 * 2 : cA; const char* nB = has_next ? (const char*)g.Bt + (size_t)nxt.pn * tstep + (size_t)nxt.k0 * 2 : cB;
        const int nt = cur.nt;
        for (int t = 0; t < nt; t += 2) {
            const bool last = (t == nt - 2);
            const char* a1 = cA + (size_t)(t + 1) * kstep;
            const char* a2 = last ? nA : cA + (size_t)(t + 2) * kstep; const char* b2 = last ? nB : cB + (size_t)(t + 2) * kstep;
            const char* a3 = a2 + kstep; const char* b3 = b2 + kstep;
            if (last && has_next) S.a_ready(nxt);
            if constexpr (SP2) {
            PG8_LDB(B0, 0, 0); PG8_LDB(B1, 0, 1); PG8_SCHED; PG8_LDA(At, 0, 0); PG8_STAGE(PG8_SA(1, 1), a1 + hstep, voffA);
            PG8_WAIT_V(8); PG8_WAIT_L(0); PG8_BAR; PG8_MMA(0, 0, At, B0); PG8_MMA(0, 1, At, B1); PG8_BAR; PG8_SCHED;
            PG8_LDA(At, 0, 1); PG8_STAGE(PG8_SB(0, 0), b2, voffB); PG8_STAGE(PG8_SB(0, 1), b2 + hstep, voffB); PG8_STAGE(PG8_SA(0, 0), a2, voffA);
            PG8_WAIT_V(8); PG8_WAIT_L(0); PG8_BAR; PG8_MMA(1, 0, At, B0); PG8_MMA(1, 1, At, B1); PG8_BAR; PG8_SCHED;
            PG8_LDB(B0, 1, 0); PG8_LDB(B1, 1, 1); PG8_SCHED; PG8_LDA(At, 1, 0); PG8_STAGE(PG8_SA(0, 1), a2 + hstep, voffA);
            PG8_WAIT_V(8); PG8_WAIT_L(0); PG8_BAR; PG8_MMA(0, 0, At, B0); PG8_MMA(0, 1, At, B1); PG8_BAR; PG8_SCHED;
            PG8_LDA(At, 1, 1); PG8_STAGE(PG8_SB(1, 0), b3, voffB); PG8_STAGE(PG8_SB(1, 1), b3 + hstep, voffB); PG8_STAGE(PG8_SA(1, 0), a3, voffA);
            PG8_WAIT_V(8); PG8_WAIT_L(0); PG8_BAR; PG8_MMA(1, 0, At, B0); PG8_MMA(1, 1, At, B1); PG8_BAR; PG8_SCHED;
            } else {
            PG8_LDB(B0, 0, 0); PG8_SCHED; PG8_LDA(At, 0, 0); PG8_STAGE(PG8_SA(1, 1), a1 + hstep, voffA);
            PG8_WAIT_L(8); PG8_BAR; PG8_WAIT_L(0); PG8_MMA(0, 0, At, B0); PG8_BAR; PG8_SCHED;
            PG8_LDB(B1, 0, 1); PG8_STAGE(PG8_SB(0, 0), b2, voffB);
            PG8_BAR; PG8_WAIT_L(0); PG8_MMA(0, 1, At, B1); PG8_BAR;
            PG8_LDA(At, 0, 1); PG8_STAGE(PG8_SA(0, 0), a2, voffA);
            PG8_BAR; PG8_WAIT_L(0); PG8_MMA(1, 0, At, B0); PG8_BAR; PG8_SCHED;
            PG8_STAGE(PG8_SB(0, 1), b2 + hstep, voffB);
            PG8_WAIT_V(6); PG8_BAR; PG8_MMA(1, 1, At, B1); PG8_BAR;
            PG8_LDB(B0, 1, 0); PG8_SCHED; PG8_LDA(At, 1, 0); PG8_STAGE(PG8_SA(0, 1), a2 + hstep, voffA);
            PG8_WAIT_L(8); PG8_BAR; PG8_WAIT_L(0); PG8_MMA(0, 0, At, B0); PG8_BAR; PG8_SCHED;
            PG8_LDB(B1, 1, 1); PG8_STAGE(PG8_SB(1, 0), b3, voffB);
            PG8_BAR; PG8_WAIT_L(0); PG8_MMA(0, 1, At, B1); PG8_BAR;
            PG8_LDA(At, 1, 1); PG8_STAGE(PG8_SA(1, 0), a3, voffA);
            PG8_BAR; PG8_WAIT_L(0); PG8_MMA(1, 0, At, B0); PG8_BAR; PG8_SCHED;
            PG8_STAGE(PG8_SB(1, 1), b3 + hstep, voffB);
            PG8_WAIT_V(6); PG8_BAR; PG8_MMA(1, 1, At, B1); PG8_BAR;
            }
        }
        if constexpr (ALIGN_EPI) { if (wr == 0) PG8_BAR; }
        if constexpr (!Epi::AFTER_DRAIN) { E(acc, cur, wr, wc, fr, fq); S.done(cur); }
        if (!has_next) break;
#pragma unroll
        for (int a = 0; a < 2; ++a)
#pragma unroll
            for (int b = 0; b < 2; ++b)
#pragma unroll
                for (int m = 0; m < 4; ++m)
#pragma unroll
                    for (int n = 0; n < 2; ++n) acc[a][b][m][n] = (f32x4){0.f, 0.f, 0.f, 0.f};
        cur = nxt; cA = nA; cB = nB; ++ui;
        if constexpr (ALIGN_EPI) { if (wr == 1) PG8_BAR; }
    }
    PG8_WAIT_V(0);
    if constexpr (!ALIGN_EPI) { if (wr == 0) PG8_BAR; }
    PG8_BAR;
    if constexpr (Epi::AFTER_DRAIN) { E.fused(acc, cur, wr, wc, fr, fq, lds, wid, lane); S.done(cur); }
#undef PG8_SA
#undef PG8_SB
#undef PG8_STAGE
#undef PG8_LDA
#undef PG8_LDB
#undef PG8_MMA
#undef PG8_WAIT_V
#undef PG8_WAIT_L
#undef PG8_BAR
#undef PG8_SCHED
}
}
#define LAS __attribute__((address_space(3)))
typedef unsigned short bf16_t;
typedef short bf16x8 __attribute__((ext_vector_type(8)));
typedef short s16x4 __attribute__((ext_vector_type(4)));
typedef float f32x4 __attribute__((ext_vector_type(4)));
typedef float f32x16 __attribute__((ext_vector_type(16)));
typedef unsigned u32x4 __attribute__((ext_vector_type(4)));
typedef unsigned u32x2 __attribute__((ext_vector_type(2)));
using pg8::cvt_pk_bf16;

constexpr int DM = 1024, NB = 8, SEQL = 2048, CTXL = 256, ML = NB * SEQL, MC = NB * CTXL, MT = ML + MC, FFH = 2816;
constexpr float EPSV = 1e-6f, LOG2E = 1.4426950408889634f, C2S = 0.125f * 1.4426950408889634f;
constexpr size_t MiB = 1u << 20;
constexpr size_t WS_WQKV = 0, WS_WO = 12 * MiB, WS_WF1 = 16 * MiB, WS_WF2 = 27 * MiB;
constexpr size_t WS_XC = 34 * MiB, WS_MODS = 42 * MiB, WS_TAB = 43 * MiB, WS_H = 44 * MiB, WS_R = 80 * MiB;
constexpr size_t WS_NEED = 368 * MiB;
constexpr size_t WS_BAR = WS_TAB + 512 * 1024;
constexpr int LDS_BYTES = 160 * 1024;

struct Params {
    const float *x, *c, *ctx, *c_ctx, *w_ada, *b_ada, *norm_g, *ffn_in, *ffn_out, *final_g, *da_w_qkv, *da_w_o, *da_lambda, *da_subln,
        *ret_w_in, *ret_w_o, *ret_decay, *na_w_qkv, *na_w_o, *na_rpb;
    float* out; unsigned char* ws;
};

__device__ __forceinline__ float shx(float v, int mask, int lane) { return __uint_as_float((unsigned)__builtin_amdgcn_ds_bpermute((lane ^ mask) << 2, (int)__float_as_uint(v))); }
__device__ __forceinline__ float wave_sum(float v, int lane) {
#pragma unroll
    for (int o = 1; o < 64; o <<= 1) v += shx(v, o, lane);
    return v;
}
__device__ __forceinline__ int crow(int r, int h) { return (r & 3) + 8 * (r >> 2) + 4 * h; }
__device__ __forceinline__ float bf2f(unsigned short b) { return __uint_as_float((unsigned)b << 16); }
__device__ __forceinline__ bf16x8 pack8(float a0, float a1, float a2, float a3, float a4, float a5, float a6, float a7) {
    u32x4 w; w.x = cvt_pk_bf16(a0, a1); w.y = cvt_pk_bf16(a2, a3); w.z = cvt_pk_bf16(a4, a5); w.w = cvt_pk_bf16(a6, a7);
    return __builtin_bit_cast(bf16x8, w);
}
__device__ __forceinline__ s16x4 vtr(const LAS unsigned char* p) {
    typedef short v4i16_t __attribute__((ext_vector_type(4)));
    return __builtin_bit_cast(s16x4, __builtin_amdgcn_ds_read_tr16_b64_v4i16((LAS v4i16_t*)p));
}
__device__ __forceinline__ bf16x8 cat4(s16x4 a, s16x4 b) { return (bf16x8){a[0], a[1], a[2], a[3], b[0], b[1], b[2], b[3]}; }
__device__ __forceinline__ float silu_f(float v) { return v * __builtin_amdgcn_rcpf(1.f + __builtin_amdgcn_exp2f(-v * LOG2E)); }

template <int MODE> struct EpiQKV {
    static constexpr bool PERM = true, AFTER_DRAIN = false;
    unsigned char* R; const float* tab;
    __device__ __forceinline__ void operator()(const f32x4 (&acc)[2][2][4][2], const pg8::Unit& u, int wr, int wc, int fr, int fq) const {
        const int row0 = u.pm * 256 + wr * 64 + fr;
        bf16_t* base; int ld, colt; int kind;
        if (MODE == 2) {
            if (u.pn < 4) { base = (bf16_t*)R; ld = 1024; colt = u.pn * 256; kind = 1; }
            else if (u.pn < 8) { base = (bf16_t*)(R + 36 * MiB); ld = 1024; colt = (u.pn - 4) * 256; kind = 2; }
            else if (u.pn < 16) { base = (bf16_t*)(R + 72 * MiB); ld = 2048; colt = (u.pn - 8) * 256; kind = 0; }
            else { base = (bf16_t*)(R + 144 * MiB); ld = 2048; colt = (u.pn - 16) * 256; kind = 3; }
        } else {
            const int sec = u.pn >> 2; base = (bf16_t*)(R + (size_t)sec * 36 * MiB); ld = 1024; colt = (u.pn & 3) * 256; kind = (MODE == 0 && sec < 2) ? 1 : 0;
        }
        const bool latent = u.pm < 64;
        if (!latent && (kind == 1 || kind == 2)) kind = (kind == 2) ? 4 : 0;
        const float ksc = 0.0625f;
#pragma unroll
        for (int ai = 0; ai < 2; ++ai)
#pragma unroll
            for (int m = 0; m < 4; ++m) {
                const int row = row0 + ai * 128 + m * 16;
                bf16_t* rowp = base + (size_t)row * ld + colt + wc * 32 + 8 * fq;
                const int t = row & 2047, grow = t >> 6, gcol = t & 63;
#pragma unroll
                for (int bj = 0; bj < 2; ++bj) {
                    f32x4 v0 = acc[ai][bj][m][0], v1 = acc[ai][bj][m][1];
                    if (kind == 1 || kind == 2) {
                        f32x4 cs, sn;
                        if (MODE == 0) { const int pos = (wc & 1) ? gcol : grow; const float* tp = tab + pos * 16 + 4 * fq; cs = *(const f32x4*)tp; sn = *(const f32x4*)(tp + 1024); }
                        else { const int pos = bj ? gcol : grow; const float* tp = tab + 2048 + pos * 64 + 16 * wc + 4 * fq; cs = *(const f32x4*)tp; sn = *(const f32x4*)(tp + 4096); }
                        const f32x4 o0 = v0 * cs - v1 * sn, o1 = v0 * sn + v1 * cs; v0 = o0; v1 = o1;
                    }
                    if (kind == 2 || kind == 4) { v0 = v0 * ksc; v1 = v1 * ksc; }
                    if (kind == 3) {
#pragma unroll
                        for (int e = 0; e < 4; ++e) { v0[e] = silu_f(v0[e]); v1[e] = silu_f(v1[e]); }
                    }
                    u32x4 w; w.x = cvt_pk_bf16(v0[0], v0[1]); w.y = cvt_pk_bf16(v0[2], v0[3]); w.z = cvt_pk_bf16(v1[0], v1[1]); w.w = cvt_pk_bf16(v1[2], v1[3]);
                    *(u32x4*)(rowp + bj * 128) = w;
                }
            }
    }
};
struct EpiSwiglu {
    static constexpr bool PERM = true, AFTER_DRAIN = false;
    bf16_t* O;
    __device__ __forceinline__ void operator()(const f32x4 (&acc)[2][2][4][2], const pg8::Unit& u, int wr, int wc, int fr, int fq) const {
        const int row0 = u.pm * 256 + wr * 64 + fr, col0 = (u.pn * 256 + wc * 32 + 8 * fq) >> 1;
#pragma unroll
        for (int ai = 0; ai < 2; ++ai)
#pragma unroll
            for (int m = 0; m < 4; ++m) {
                bf16_t* rowp = O + (size_t)(row0 + ai * 128 + m * 16) * FFH + col0;
#pragma unroll
                for (int bj = 0; bj < 2; ++bj) {
                    const f32x4 a = acc[ai][bj][m][0], b = acc[ai][bj][m][1];
                    u32x2 w; w.x = cvt_pk_bf16(silu_f(a[0]) * b[0], silu_f(a[1]) * b[1]); w.y = cvt_pk_bf16(silu_f(a[2]) * b[2], silu_f(a[3]) * b[3]);
                    *(u32x2*)(rowp + bj * 64) = w;
                }
            }
    }
};
template <int KT> struct EpiRes {
    static constexpr bool PERM = false, AFTER_DRAIN = false;
    float* XL; float* XC; const float* gate; float gs; float* PB;
    __device__ __forceinline__ void operator()(const f32x4 (&acc)[2][2][4][2], const pg8::Unit& u, int wr, int wc, int fr, int fq) const {
        const int row0 = u.pm * 256 + wr * 64 + fr, col0 = u.pn * 256 + wc * 32 + 4 * fq;
        const int mi = u.pm < 64 ? (u.pm >> 3) : 8;
        const bool split = u.nt != KT;
        float* xb = u.pm < 64 ? XL : (XC - (size_t)ML * DM);
        const ptrdiff_t pboff = split ? (PB + (size_t)u.part * MC * DM) - XC : 0;
        const float* gp = gate + mi * 6144 + col0;
        f32x4 gv[2][2];
#pragma unroll
        for (int bj = 0; bj < 2; ++bj)
#pragma unroll
            for (int n = 0; n < 2; ++n) gv[bj][n] = *(const f32x4*)(gp + bj * 128 + n * 16) * gs;
#pragma unroll
        for (int ai = 0; ai < 2; ++ai)
#pragma unroll
            for (int m = 0; m < 4; ++m) {
                float* rowp = xb + (size_t)(row0 + ai * 128 + m * 16) * DM + col0;
#pragma unroll
                for (int bj = 0; bj < 2; ++bj)
#pragma unroll
                    for (int n = 0; n < 2; ++n) {
                        const f32x4 v = gv[bj][n] * acc[ai][bj][m][n]; float* pe = rowp + bj * 128 + n * 16;
                        if (split) *(f32x4*)(pe + pboff) = v;
                        else { f32x4* p = (f32x4*)pe; *p = *p + v; }
                    }
            }
    }
};
template <int NN, int KT> struct Order8 {
    int nwg, G, c;
    __device__ __forceinline__ void init(int M, int G_, int c_) { nwg = (M / 256) * NN; G = G_; c = c_; }
    __device__ __forceinline__ bool next(int i, pg8::Unit& u) const {
        const int L = i * G + c; if (L >= nwg) return false;
        const int q = nwg >> 3, xcd = L & 7, off = L >> 3; const int wgid = xcd * q + off;
        constexpr int nig = 8 * NN; const int gid = wgid / nig, rem = wgid - gid * nig;
        u.pm = gid * 8 + (rem & 7); u.pn = rem >> 3; u.k0 = 0; u.nt = KT; u.part = 0; return true;
    }
    __device__ __forceinline__ void a_ready(const pg8::Unit&) const {}
    __device__ __forceinline__ void done(const pg8::Unit&) const {}
};
template <int K, int NS> struct OrderSplitK {
    int nlat, ntot, G, c;
    __device__ __forceinline__ void init(int M, int G_, int c_) { nlat = 256; ntot = 256 + (M > ML ? 32 * NS : 0); G = G_; c = c_; }
    __device__ __forceinline__ bool next(int i, pg8::Unit& u) const {
        const int L = i * G + c; if (L >= ntot) return false;
        if (L < nlat) { const int xcd = L & 7, off = L >> 3; const int wgid = xcd * 32 + off; const int gid = wgid >> 5, rem = wgid & 31; u.pm = gid * 8 + (rem & 7); u.pn = rem >> 3; u.k0 = 0; u.nt = K / 64; u.part = 0; return true; }
        const int s = L - nlat, t = s / NS, part = s - t * NS;
        constexpr int K128 = K / 128, base = K128 / NS, extra = K128 - base * NS;
        const int b0 = part * base + (part < extra ? part : extra), nb = base + (part < extra ? 1 : 0);
        u.pm = 64 + (t >> 2); u.pn = t & 3; u.k0 = b0 * 128; u.nt = nb * 2; u.part = part; return true;
    }
    __device__ __forceinline__ void a_ready(const pg8::Unit&) const {}
    __device__ __forceinline__ void done(const pg8::Unit&) const {}
};
template <int K, int NS, class Epi> __device__ __forceinline__ void run_gemm_res(LAS unsigned char* lds, const bf16_t* A, const bf16_t* Bt, int M, const Epi& E) {
    static_assert((K / 128) / NS >= 2, "every K part needs at least 256 of K");
    pg8::Gemm g{A, Bt, M, 1024, K}; OrderSplitK<K, NS> S; S.init(M, lgrid(), lbid());
    pg8::gemm_phase<Epi, OrderSplitK<K, NS>, true, true>(lds, g, S, E);
}
template <int N, int K, class Epi> __device__ __forceinline__ void run_gemm(LAS unsigned char* lds, const bf16_t* A, const bf16_t* Bt, int M, const Epi& E) {
    pg8::Gemm g{A, Bt, M, N, K}; Order8<N / 256, K / 64> S; S.init(M, lgrid(), lbid());
    pg8::gemm_phase<Epi, Order8<N / 256, K / 64>, true, true>(lds, g, S, E);
}

__device__ __forceinline__ int srccol(int g, int lim, int grp, int P) {
    if (g >= lim) return g;
    const int base = (g / grp) * grp, gl = g - base, u = gl >> 3, j = gl & 7;
    return base + 4 * u + (j & 3) + P * (j >> 2);
}
__device__ __forceinline__ void cvt_item(const float* __restrict__ W, int K, int N, bf16_t* WT, float* scr, int item, int lane, int lim, int grp, int P) {
    const int nblk = N / 32, kb = item / nblk, nb = item - kb * nblk, k0 = 64 * kb, n0 = 32 * nb;
    const int sc = srccol(n0 + (lane & 31), lim, grp, P);
#pragma unroll 8
    for (int i = 0; i < 32; ++i) { const int kk = 2 * i + (lane >> 5); scr[kk * 33 + (lane & 31)] = W[(size_t)(k0 + kk) * N + sc]; }
    __builtin_amdgcn_s_waitcnt(0); asm volatile("" ::: "memory");
    const int c = lane & 7;
#pragma unroll
    for (int j = 0; j < 4; ++j) {
        const int n = (lane >> 3) + 8 * j; const float* s = scr + (8 * c) * 33 + n;
        u32x4 o; o.x = cvt_pk_bf16(s[0], s[33]); o.y = cvt_pk_bf16(s[66], s[99]); o.z = cvt_pk_bf16(s[132], s[165]); o.w = cvt_pk_bf16(s[198], s[231]);
        *(u32x4*)(WT + (size_t)(n0 + n) * K + k0 + 8 * c) = o;
    }
    __builtin_amdgcn_s_waitcnt(0); asm volatile("" ::: "memory");
}
template <int NP> __device__ __forceinline__ void mod_row(float* xrow, const float* prow, const float* g, const float* sh, const float* sc, bf16_t* orow, int lane) {
    f32x4 v[4]; float s = 0.f;
#pragma unroll
    for (int j = 0; j < 4; ++j) { v[j] = *(const f32x4*)(xrow + 4 * lane + 256 * j);
        if (NP > 0) {
#pragma unroll
            for (int q = 0; q < NP; ++q) v[j] = v[j] + *(const f32x4*)(prow + (size_t)q * MC * DM + 4 * lane + 256 * j);
            *(f32x4*)(xrow + 4 * lane + 256 * j) = v[j]; }
        s += (v[j].x * v[j].x + v[j].y * v[j].y) + (v[j].z * v[j].z + v[j].w * v[j].w); }
    const float rstd = rsqrtf(wave_sum(s, lane) * (1.f / DM) + EPSV);
#pragma unroll
    for (int j = 0; j < 4; ++j) {
        const int c = 4 * lane + 256 * j;
        const f32x4 gg = *(const f32x4*)(g + c), ss = *(const f32x4*)(sc + c), hh = *(const f32x4*)(sh + c);
        const f32x4 o = v[j] * rstd * gg * (ss + 1.0f) + hh;
        u32x2 w; w.x = cvt_pk_bf16(o.x, o.y); w.y = cvt_pk_bf16(o.z, o.w);
        *(u32x2*)(orow + c) = w;
    }
}
#define XB_TMO      128
#define XB_XCNT(j)  (256  + 64 * (j))
#define XB_XSUB(j)  (1280 + 64 * (j))
#define XB_XGEN(j)  (2304 + 64 * (j))
#define XB_TOP      3328
#define XB_TOPGEN   3392
#define XCD_BAR_WORDS 3456
#define XB_SPIN_CAP (1u << 18)

__device__ __forceinline__ unsigned xb_ld(unsigned* p)              { return __hip_atomic_load(p, __ATOMIC_RELAXED, __HIP_MEMORY_SCOPE_AGENT); }
__device__ __forceinline__ unsigned xb_add(unsigned* p, unsigned v) { return __hip_atomic_fetch_add(p, v, __ATOMIC_RELAXED, __HIP_MEMORY_SCOPE_AGENT); }
__device__ __forceinline__ unsigned xb_xcc_id() { return (unsigned)__builtin_amdgcn_s_getreg((3 << 11) | 20) & 0xFu; }
#define XB_SPIN(cond, bar) do { unsigned _sp = 0; while (cond) { __builtin_amdgcn_s_sleep(1); \
    if ((++_sp & 255u) == 0u) { if (xb_ld(&(bar)[XB_TMO])) break; if (_sp > XB_SPIN_CAP) { atomicAdd(&(bar)[XB_TMO], 1u); break; } } } } while (0)

struct XcdBarrier {
    unsigned* bar; unsigned x;
    volatile LAS unsigned* st;
};

__device__ __forceinline__ XcdBarrier xcd_barrier_post(unsigned* bar, volatile LAS unsigned* st) {
    XcdBarrier b; b.bar = bar; b.x = xb_xcc_id(); b.st = st;
    if (threadIdx.x == 0) (void)xb_add(&bar[XB_XCNT(b.x)], 1u);
    return b;
}
__device__ __forceinline__ void xcd_barrier_complete(unsigned* bar, unsigned x, unsigned& nloc, unsigned& nx) {
    const unsigned G = gridDim.x * gridDim.y * gridDim.z;
    unsigned sum, cnt, mine, sp = 0u;
    for (;;) {
        sum = 0u; cnt = 0u; mine = 0u;
#pragma unroll
        for (unsigned j = 0; j < 16; ++j) { const unsigned c = xb_ld(&bar[XB_XCNT(j)]); sum += c; cnt += (c > 0u) ? 1u : 0u; mine = (j == x) ? c : mine; }
        if (sum == G) break;
        __builtin_amdgcn_s_sleep(1);
        if ((++sp & 255u) == 0u) { if (xb_ld(&bar[XB_TMO])) break; if (sp > XB_SPIN_CAP) { atomicAdd(&bar[XB_TMO], 1u); break; } }
    }
    nloc = mine > 0u ? mine : 1u; nx = cnt > 0u ? cnt : 1u;
}

__device__ __forceinline__ void xcd_barrier(const XcdBarrier& b) {
    asm volatile("s_waitcnt vmcnt(0)" ::: "memory");
    __syncthreads();
    if (threadIdx.x == 0) {
        unsigned* bar = b.bar;
        __builtin_amdgcn_s_waitcnt(0);
        unsigned nloc = b.st[0], nx = b.st[1];
        if (nloc == 0u) { xcd_barrier_complete(bar, b.x, nloc, nx); b.st[0] = nloc; b.st[1] = nx; }
        const unsigned old = xb_add(&bar[XB_XSUB(b.x)], 1u);
        const unsigned gen = old / nloc;
        if (old + 1u == (gen + 1u) * nloc) {
            __builtin_amdgcn_fence(__ATOMIC_RELEASE, "agent");
            asm volatile("s_waitcnt vmcnt(0)" ::: "memory");
            const unsigned og = xb_add(&bar[XB_TOP], 1u);
            const unsigned tg = og / nx;
            if (og + 1u == (tg + 1u) * nx) xb_add(&bar[XB_TOPGEN], 1u);
            else XB_SPIN(xb_ld(&bar[XB_TOPGEN]) == tg, bar);
            __builtin_amdgcn_fence(__ATOMIC_ACQUIRE, "agent");
            xb_add(&bar[XB_XGEN(b.x)], 1u);
            asm volatile("s_waitcnt vmcnt(0)" ::: "memory");
        } else {
            XB_SPIN(xb_ld(&bar[XB_XGEN(b.x)]) == gen, bar);
            __builtin_amdgcn_fence(__ATOMIC_ACQUIRE, "agent");
            asm volatile("s_waitcnt vmcnt(0)" ::: "memory");
        }
    }
    __syncthreads();
}
constexpr int FA_KT = 64 * 144;
template <int DV, bool SPLIT = false> struct FaCfg { static constexpr int KROW = SPLIT ? 272 : 144, KT = 64 * KROW, VROW = DV * 2 + 64, VT = 64 * VROW, KOFF = 0, VOFF = 2 * KT, SCR = VOFF + 2 * VT, RPB = SCR + 8 * 32 * 4; };

template <int DV, bool BIAS, bool SPLIT = false>
__device__ __forceinline__ void flash_unit(unsigned char* smem, const bf16_t* __restrict__ Qg, const bf16_t* __restrict__ Kg, const bf16_t* __restrict__ Vg,
                                           int nlat, int lat_row0, int nctx, int ctx_row0, int kr0, int qr, int c0, float* outF, bf16_t* outB, float lam = 0.f, float osc = 0.f, const float* subg = nullptr) {
    typedef FaCfg<DV, SPLIT> C;
    constexpr int NDB = DV / 32;
    const int tid = ltid(), lane = tid & 63, w = tid >> 6, h2 = lane >> 5, l31 = lane & 31;
    LAS unsigned char* lds = (LAS unsigned char*)smem;
    float* scr = (float*)(smem + C::SCR) + w * 32;
    const float* rpbL = (const float*)(smem + C::RPB);
    const int nt = nlat + nctx;
    const int krow = tid >> 3, kch = tid & 7;
    u32x4 kreg, kreg2, vreg0, vreg1;
    auto tile_row = [&](int t) { return t < nlat ? lat_row0 + 64 * t : ctx_row0 + 64 * (t - nlat); };
#define FA_LOADK(t) do { const int rg_ = tile_row(t); if (SPLIT) { kreg = *(const u32x4*)(Kg + (size_t)(rg_ + (tid >> 4)) * 1024 + (tid & 15) * 8); kreg2 = *(const u32x4*)(Kg + (size_t)(rg_ + 32 + (tid >> 4)) * 1024 + (tid & 15) * 8); } \
        else kreg = *(const u32x4*)(Kg + (size_t)(rg_ + krow) * 1024 + kch * 8); } while (0)
#define FA_LOADV(t) do { const int rg_ = tile_row(t); \
        if (DV == 128) { vreg0 = *(const u32x4*)(Vg + (size_t)(rg_ + (tid >> 4)) * 1024 + (tid & 15) * 8); vreg1 = *(const u32x4*)(Vg + (size_t)(rg_ + 32 + (tid >> 4)) * 1024 + (tid & 15) * 8); } \
        else { vreg0 = *(const u32x4*)(Vg + (size_t)(rg_ + krow) * 1024 + kch * 8); } } while (0)
#define FA_STOREK(buf) do { if (SPLIT) { *(LAS u32x4*)(lds + C::KOFF + (buf) * C::KT + (tid >> 4) * C::KROW + (tid & 15) * 16) = kreg; *(LAS u32x4*)(lds + C::KOFF + (buf) * C::KT + (32 + (tid >> 4)) * C::KROW + (tid & 15) * 16) = kreg2; } \
        else *(LAS u32x4*)(lds + C::KOFF + (buf) * C::KT + krow * C::KROW + kch * 16) = kreg; } while (0)
#define FA_STOREV(buf) do { \
        if (DV == 128) { *(LAS u32x4*)(lds + C::VOFF + (buf) * C::VT + (tid >> 4) * C::VROW + (tid & 15) * 16) = vreg0; *(LAS u32x4*)(lds + C::VOFF + (buf) * C::VT + (32 + (tid >> 4)) * C::VROW + (tid & 15) * 16) = vreg1; } \
        else { *(LAS u32x4*)(lds + C::VOFF + (buf) * C::VT + krow * C::VROW + kch * 16) = vreg0; } } while (0)
    bf16x8 qf[4];
#pragma unroll
    for (int ks = 0; ks < 4; ++ks) qf[ks] = *(const bf16x8*)(Qg + (size_t)l31 * 1024 + ks * 16 + h2 * 8);
    f32x16 O[NDB];
#pragma unroll
    for (int d = 0; d < NDB; ++d)
#pragma unroll
        for (int r = 0; r < 16; ++r) O[d][r] = 0.f;
    float mrun = -1e30f, lsum = 0.f;
    const int rs = qr - 4 < 0 ? 0 : (qr - 4 > 24 ? 24 : qr - 4);
    const int qc = c0 + l31, cs = qc - 8 < 0 ? 0 : (qc - 8 > 48 ? 48 : qc - 8);
    const int vlane = ((lane >> 4) & 1) * 32 + (lane & 3) * 8 + (4 * h2 + ((lane & 15) >> 2)) * C::VROW;
    FA_LOADK(0); FA_LOADV(0); FA_STOREK(0); FA_STOREV(0);
    if (nt > 1) { FA_LOADK(1); FA_STOREK(1); }
    __syncthreads();
    auto tile_act = [&](int t) { bool a = true; if (BIAS && t < nlat) { const int kr = kr0 + t; a = (kr >= rs) && (kr <= rs + 7); } return a; };
#define FA_QK(S0, S1, t_) do { const LAS unsigned char* kb = lds + C::KOFF + ((t_) & 1) * C::KT + l31 * C::KROW + h2 * 16 + (SPLIT ? (w >> 2) * 128 : 0); \
        _Pragma("unroll") for (int r = 0; r < 16; ++r) { S0[r] = 0.f; S1[r] = 0.f; } \
        _Pragma("unroll") for (int ks = 0; ks < 4; ++ks) { const bf16x8 a0_ = *(const LAS bf16x8*)(kb + ks * 32), a1_ = *(const LAS bf16x8*)(kb + 32 * C::KROW + ks * 32); \
            S0 = __builtin_amdgcn_mfma_f32_32x32x16_bf16(a0_, qf[ks], S0, 0, 0, 0); S1 = __builtin_amdgcn_mfma_f32_32x32x16_bf16(a1_, qf[ks], S1, 0, 0, 0); } } while (0)
    f32x16 sA0, sA1, sB0, sB1;
    if (tile_act(0)) FA_QK(sA0, sA1, 0);
    asm volatile("s_nop 15\n\ts_nop 7" : "+v"(sA0), "+v"(sA1));
    auto step = [&](f32x16& s0, f32x16& s1, f32x16& n0, f32x16& n1, const int t) __attribute__((always_inline)) {
        const int buf = t & 1;
        if (t + 2 < nt) FA_LOADK(t + 2);
        if (t + 1 < nt) FA_LOADV(t + 1);
        if (tile_act(t)) {
            float mx;
            const bool biased = BIAS && t < nlat;
            if (biased) {
                const int drow = (kr0 + t - qr + 7) * 32;
                int qcl = qc, csl = cs; asm volatile("" : "+v"(qcl), "+v"(csl));
#pragma unroll
                for (int r = 0; r < 16; ++r) {
                    const int k0 = crow(r, h2), k1 = k0 + 32;
                    int d0 = k0 - qcl + 15, d1 = k1 - qcl + 15; d0 = d0 < 0 ? 0 : (d0 > 30 ? 30 : d0); d1 = d1 < 0 ? 0 : (d1 > 30 ? 30 : d1);
                    const float b0 = rpbL[drow + d0], b1 = rpbL[drow + d1];
                    s0[r] = ((unsigned)(k0 - csl) < 16u) ? s0[r] * C2S + b0 * LOG2E : -1e30f;
                    s1[r] = ((unsigned)(k1 - csl) < 16u) ? s1[r] * C2S + b1 * LOG2E : -1e30f;
                }
            }
            {
                float ma, mb;
                asm volatile("s_nop 4" : "+v"(s0), "+v"(s1));
                asm("v_max3_f32 %0, %1, %2, %3" : "=v"(ma) : "v"(s0[0]), "v"(s0[1]), "v"(s1[0]));
                asm("v_max3_f32 %0, %1, %2, %3" : "=v"(mb) : "v"(s1[1]), "v"(s0[2]), "v"(s1[2]));
#pragma unroll
                for (int r = 3; r < 15; r += 2) {
                    asm("v_max3_f32 %0, %1, %2, %3" : "=v"(ma) : "v"(ma), "v"(s0[r]), "v"(s1[r]));
                    asm("v_max3_f32 %0, %1, %2, %3" : "=v"(mb) : "v"(mb), "v"(s0[r + 1]), "v"(s1[r + 1]));
                }
                asm("v_max3_f32 %0, %1, %2, %3" : "=v"(ma) : "v"(ma), "v"(s0[15]), "v"(s1[15]));
                asm("v_max_f32_e32 %0, %1, %2" : "=v"(mx) : "v"(ma), "v"(mb));
            }
            if (!biased) mx *= C2S;
            mx = fmaxf(mx, shx(mx, 32, lane));
            const bool grew = mx > mrun + 8.0f;
            const float mnew = grew ? mx : mrun, alpha = __builtin_amdgcn_exp2f(mrun - mnew);
            mrun = mnew;
            const float alpha_l = alpha;
            if (__builtin_amdgcn_ballot_w64(grew) != 0ull) {
                if (h2 == 0) scr[l31] = alpha;
                asm volatile("s_waitcnt lgkmcnt(0)" ::: "memory");
                float al[16];
#pragma unroll
                for (int r = 0; r < 16; ++r) al[r] = scr[crow(r, h2)];
#pragma unroll
                for (int d = 0; d < NDB; ++d)
#pragma unroll
                    for (int r = 0; r < 16; ++r) O[d][r] *= al[r];
            }
            bf16x8 pa[4];
            {
                const LAS unsigned char* kbn = lds + C::KOFF + ((t + 1) & 1) * C::KT + l31 * C::KROW + h2 * 16 + (SPLIT ? (w >> 2) * 128 : 0);
                bf16x8 ka0[4], ka1[4];
#pragma unroll
                for (int ks = 0; ks < 4; ++ks) { ka0[ks] = *(const LAS bf16x8*)(kbn + ks * 32); ka1[ks] = *(const LAS bf16x8*)(kbn + 32 * C::KROW + ks * 32); }
#pragma unroll
                for (int r = 0; r < 16; ++r) { n0[r] = 0.f; n1[r] = 0.f; }
                __builtin_amdgcn_sched_barrier(0);
#pragma unroll
                for (int ks = 0; ks < 4; ++ks) { n0 = __builtin_amdgcn_mfma_f32_32x32x16_bf16(ka0[ks], qf[ks], n0, 0, 0, 0); n1 = __builtin_amdgcn_mfma_f32_32x32x16_bf16(ka1[ks], qf[ks], n1, 0, 0, 0); }
            float ps = 0.f;
            if (biased) {
#pragma unroll
                for (int r = 0; r < 16; ++r) { s0[r] = __builtin_amdgcn_exp2f(s0[r] - mnew); s1[r] = __builtin_amdgcn_exp2f(s1[r] - mnew); ps += s0[r] + s1[r]; }
            } else {
#pragma unroll
                for (int r = 0; r < 16; ++r) { s0[r] = __builtin_amdgcn_exp2f(fmaf(s0[r], C2S, -mnew)); s1[r] = __builtin_amdgcn_exp2f(fmaf(s1[r], C2S, -mnew)); ps += s0[r] + s1[r]; }
            }
            lsum = lsum * alpha_l + ps;
            pa[0] = pack8(s0[0], s0[1], s0[2], s0[3], s0[4], s0[5], s0[6], s0[7]);
            pa[1] = pack8(s0[8], s0[9], s0[10], s0[11], s0[12], s0[13], s0[14], s0[15]);
            pa[2] = pack8(s1[0], s1[1], s1[2], s1[3], s1[4], s1[5], s1[6], s1[7]);
            pa[3] = pack8(s1[8], s1[9], s1[10], s1[11], s1[12], s1[13], s1[14], s1[15]);
#pragma unroll
                for (int g = 0; g < 8; ++g) { __builtin_amdgcn_sched_group_barrier(0x8, 1, 0); __builtin_amdgcn_sched_group_barrier(0x2, 16, 0); }
                __builtin_amdgcn_sched_barrier(0);
            }
            const LAS unsigned char* vb = lds + C::VOFF + buf * C::VT + vlane;
            bf16x8 vfr[2][4];
#pragma unroll
            for (int ks = 0; ks < 4; ++ks) vfr[0][ks] = cat4(vtr(vb + ks * 16 * C::VROW), vtr(vb + (ks * 16 + 8) * C::VROW));
#pragma unroll
            for (int d = 0; d < NDB; ++d) {
                if (d + 1 < NDB) {
#pragma unroll
                    for (int ks = 0; ks < 4; ++ks) vfr[(d + 1) & 1][ks] = cat4(vtr(vb + ks * 16 * C::VROW + (d + 1) * 64), vtr(vb + (ks * 16 + 8) * C::VROW + (d + 1) * 64));
                }
                __builtin_amdgcn_sched_barrier(0);
#pragma unroll
                for (int ks = 0; ks < 4; ++ks) O[d] = __builtin_amdgcn_mfma_f32_32x32x16_bf16(pa[ks], vfr[d & 1][ks], O[d], 0, 0, 0);
                __builtin_amdgcn_sched_barrier(0);
            }
        } else { FA_QK(n0, n1, t + 1); }
        if (t + 2 < nt) FA_STOREK(buf);
        if (t + 1 < nt) FA_STOREV(buf ^ 1);
        __syncthreads();
    };
    for (int t = 0; t < nt; t += 2) {
        step(sA0, sA1, sB0, sB1, t);
        if (t + 1 < nt) step(sB0, sB1, sA0, sA1, t + 1);
    }
#undef FA_LOADK
#undef FA_LOADV
#undef FA_STOREK
#undef FA_STOREV
#undef FA_QK
    lsum += shx(lsum, 32, lane);
    if (h2 == 0) scr[l31] = 1.f / lsum;
    __builtin_amdgcn_s_waitcnt(0xc07f); asm volatile("" ::: "memory");
    if (!SPLIT) {
#pragma unroll
        for (int r = 0; r < 16; ++r) {
            const float iv = scr[crow(r, h2)]; const int row = crow(r, h2);
#pragma unroll
            for (int d = 0; d < NDB; ++d) {
                if (DV == 128) outF[(size_t)row * 2048 + d * 32 + l31] = O[d][r] * iv;
                else { const float v = O[d][r] * iv; outB[(size_t)row * 1024 + d * 32 + l31] = (bf16_t)(cvt_pk_bf16(v, v) & 0xffffu); }
            }
        }
    } else {
        float* xch = (float*)smem + (w & 3) * (NDB * 16 * 64);
#pragma unroll
        for (int r = 0; r < 16; ++r) { const float iv = scr[crow(r, h2)];
#pragma unroll
            for (int d = 0; d < NDB; ++d) O[d][r] *= iv; }
        if (w >= 4) {
#pragma unroll
            for (int d = 0; d < NDB; ++d)
#pragma unroll
                for (int r = 0; r < 16; ++r) xch[(d * 16 + r) * 64 + lane] = O[d][r] * lam;
        }
        __syncthreads();
        if (w < 4) {
            float ss[16];
#pragma unroll
            for (int r = 0; r < 16; ++r) { ss[r] = 0.f;
#pragma unroll
                for (int d = 0; d < NDB; ++d) { O[d][r] -= xch[(d * 16 + r) * 64 + lane]; ss[r] += O[d][r] * O[d][r]; } }
#pragma unroll
            for (int r = 0; r < 16; ++r) {
#pragma unroll
                for (int o = 1; o < 32; o <<= 1) ss[r] += shx(ss[r], o, lane);
                ss[r] = rsqrtf(ss[r] * (1.f / 128.f) + EPSV) * osc;
            }
#pragma unroll
            for (int d = 0; d < NDB; ++d) { const float gg = subg[d * 32 + l31];
#pragma unroll
                for (int r = 0; r < 16; ++r) { const float v = O[d][r] * ss[r] * gg; outB[(size_t)crow(r, h2) * 1024 + d * 32 + l31] = (bf16_t)(cvt_pk_bf16(v, v) & 0xffffu); } }
        }
        __syncthreads();
    }
    __builtin_amdgcn_s_waitcnt(0xc07f); asm volatile("" ::: "memory");
}
__device__ __forceinline__ void ret_p_unit(const bf16_t* __restrict__ Q, const bf16_t* __restrict__ K, bf16_t* Pt, int b, int h, int ci, float lgf, float lgb) {
    const int tid = ltid(), lane = tid & 63, w = tid >> 6, h2 = lane >> 5, l31 = lane & 31;
    const int row0 = ci < 2 ? ML + b * CTXL + 128 * ci : b * SEQL + 128 * (ci - 2);
    const int ib = w & 3, jh = w >> 2;
    const bf16_t* qp = Q + (size_t)(row0 + 32 * ib + l31) * 1024 + h * 256 + h2 * 8;
    f32x16 s[2];
#pragma unroll
    for (int jb = 0; jb < 2; ++jb)
#pragma unroll
        for (int r = 0; r < 16; ++r) s[jb][r] = 0.f;
    const bf16_t* kp0 = K + (size_t)(row0 + 64 * jh + l31) * 1024 + h * 256 + h2 * 8;
#pragma unroll 4
    for (int ks = 0; ks < 16; ++ks) {
        const bf16x8 a = *(const bf16x8*)(qp + ks * 16);
        const bf16x8 b0 = *(const bf16x8*)(kp0 + ks * 16), b1 = *(const bf16x8*)(kp0 + 32 * 1024 + ks * 16);
        s[0] = __builtin_amdgcn_mfma_f32_32x32x16_bf16(a, b0, s[0], 0, 0, 0);
        s[1] = __builtin_amdgcn_mfma_f32_32x32x16_bf16(a, b1, s[1], 0, 0, 0);
    }
    bf16_t* pf = Pt + ((size_t)((0 * 8 + b) * 4 + h) * 18 + ci) * 16384;
    bf16_t* pb = Pt + ((size_t)((1 * 8 + b) * 4 + h) * 18 + ci) * 16384;
#pragma unroll
    for (int jb = 0; jb < 2; ++jb)
#pragma unroll
        for (int r = 0; r < 16; ++r) {
            const int i = 32 * ib + crow(r, h2), j = 64 * jh + 32 * jb + l31, df = i - j;
            const float v = s[jb][r];
            const float vf = df >= 0 ? v * __builtin_amdgcn_exp2f((float)df * lgf) : 0.f;
            const float vb = df < 0 ? v * __builtin_amdgcn_exp2f((float)(-df) * lgb) : 0.f;
            pf[i * 128 + j] = (bf16_t)(cvt_pk_bf16(vf, vf) & 0xffffu);
            pb[i * 128 + j] = (bf16_t)(cvt_pk_bf16(vb, vb) & 0xffffu);
        }
}
__device__ __forceinline__ unsigned cvtpk_v(float lo, float hi) { typedef float f32x2_t __attribute__((ext_vector_type(2))); typedef __bf16 bf16x2_t __attribute__((ext_vector_type(2)));
    f32x2_t v = {lo, hi}; bf16x2_t b = __builtin_convertvector(v, bf16x2_t); return __builtin_bit_cast(unsigned, b); }
constexpr int RS_VROW = 192, RS_KROW = 576, RS_SROW = 528, RS_VOFF = 0, RS_VZOFF = 128 * RS_VROW, RS_KOFF = 2 * 128 * RS_VROW, RS_SOFF = RS_KOFF + 128 * RS_KROW;
static_assert(RS_SOFF + 64 * RS_SROW <= LDS_BYTES - 64, "retention scan LDS");
__device__ __forceinline__ void ret_scan_unit(unsigned char* smem, const bf16_t* __restrict__ Q, const bf16_t* __restrict__ K, const bf16_t* __restrict__ V,
                                              const bf16_t* __restrict__ Pt, bf16_t* OX, int b, int h, int dvs, const float* lg) {
    const int tid0 = ltid();
    LAS unsigned char* lds = (LAS unsigned char*)smem;
    for (int dir = 1; dir >= 0; --dir) {
        const float lgd = __uint_as_float(__builtin_amdgcn_readfirstlane(__float_as_uint(lg[dir * 4 + h])));
        const float gC = __uint_as_float(__builtin_amdgcn_readfirstlane(__float_as_uint(__builtin_amdgcn_exp2f(128.f * lgd))));
        f32x16 S[2];
#pragma unroll
        for (int d = 0; d < 2; ++d)
#pragma unroll
            for (int r = 0; r < 16; ++r) S[d][r] = 0.f;
        u32x4 kv[8], vv[2];
        {
            int tid = tid0; asm volatile("" : "+v"(tid));
            const int rowf = ML + b * CTXL + 128 * (dir ? 1 : 0);
#pragma unroll
            for (int i = 0; i < 8; ++i) { const int id = tid + 512 * i, r = id >> 5, ch = id & 31; kv[i] = *(const u32x4*)(K + (size_t)(rowf + r) * 1024 + h * 256 + ch * 8); }
#pragma unroll
            for (int i = 0; i < 2; ++i) { const int id = tid + 512 * i, r = id >> 3, ch = id & 7; vv[i] = *(const u32x4*)(V + (size_t)(rowf + r) * 2048 + h * 512 + dvs * 64 + ch * 8); }
        }
        for (int step = 0; step < 18; ++step) {
            int ci;
            if (step < 2) ci = dir ? 1 - step : step; else ci = dir ? 2 + (15 - (step - 2)) : step;
            const int row0 = ci < 2 ? ML + b * CTXL + 128 * ci : b * SEQL + 128 * (ci - 2);
            int tid = tid0; asm volatile("" : "+v"(tid));
            const int lane = tid & 63, w = __builtin_amdgcn_readfirstlane(tid >> 6), h2 = lane >> 5, l31 = lane & 31, dvb = w & 1, ib = w >> 1;
            const int trl = ((lane >> 4) & 1) * 32 + (lane & 3) * 8;
            const int trr = ((lane & 15) >> 2);
            bf16x8 qf[16], pfr[8];
            {
                const bf16_t* qp = Q + (size_t)(row0 + 32 * ib + l31) * 1024 + h * 256 + 8 * h2;
#pragma unroll
                for (int f = 0; f < 16; ++f) qf[f] = *(const bf16x8*)(qp + 16 * f);
                const bf16_t* pp = Pt + ((size_t)((dir * 8 + b) * 4 + h) * 18 + ci) * 16384 + (size_t)(32 * ib + l31) * 128 + 8 * h2;
#pragma unroll
                for (int ks = 0; ks < 8; ++ks) pfr[ks] = *(const bf16x8*)(pp + ks * 16);
            }
            bf16_t* op = OX + (size_t)(row0 + 32 * ib + (l31 & 3) + 4 * h2) * 2048 + h * 512 + dvs * 64 + dvb * 32 + 4 * (l31 >> 2);
            u32x2 prev2[4];
            if (dir == 0) {
#pragma unroll
                for (int j = 0; j < 4; ++j) prev2[j] = *(const u32x2*)(op + (size_t)(8 * j) * 2048);
            }
            asm volatile("s_waitcnt lgkmcnt(0)\n\ts_barrier" ::: "memory");
#pragma unroll
            for (int d = 0; d < 2; ++d)
#pragma unroll
                for (int g = 0; g < 4; ++g) {
                    u32x2 o; o.x = cvt_pk_bf16(S[d][4 * g], S[d][4 * g + 1]); o.y = cvt_pk_bf16(S[d][4 * g + 2], S[d][4 * g + 3]);
                    *(LAS u32x2*)(lds + RS_SOFF + (32 * dvb + l31) * RS_SROW + (32 * (2 * ib + d) + 8 * g + 4 * h2) * 2) = o;
                }
#pragma unroll
            for (int i = 0; i < 8; ++i) { const int id = tid + 512 * i, r = id >> 5, ch = id & 31; *(LAS u32x4*)(lds + RS_KOFF + r * RS_KROW + ch * 16) = kv[i]; }
#pragma unroll
            for (int i = 0; i < 2; ++i) {
                const int id = tid + 512 * i, r = id >> 3, ch = id & 7;
                const int jp = dir ? 127 - r : r;
                const float z = __builtin_amdgcn_exp2f((float)(127 - jp) * lgd);
                u32x4 o;
#pragma unroll
                for (int e = 0; e < 4; ++e) { const unsigned x = vv[i][e]; o[e] = cvt_pk_bf16(__uint_as_float(x << 16) * z, __uint_as_float(x & 0xffff0000u) * z); }
                *(LAS u32x4*)(lds + RS_VOFF + r * RS_VROW + ch * 16) = vv[i];
                *(LAS u32x4*)(lds + RS_VZOFF + r * RS_VROW + ch * 16) = o;
            }
            asm volatile("s_waitcnt lgkmcnt(0)\n\ts_barrier" ::: "memory");
            if (step + 1 < 18) {
                const int sn = step + 1; int cn;
                if (sn < 2) cn = dir ? 1 - sn : sn; else cn = dir ? 2 + (15 - (sn - 2)) : sn;
                const int rown = cn < 2 ? ML + b * CTXL + 128 * cn : b * SEQL + 128 * (cn - 2);
#pragma unroll
                for (int i = 0; i < 8; ++i) { const int id = tid + 512 * i, r = id >> 5, ch = id & 31; kv[i] = *(const u32x4*)(K + (size_t)(rown + r) * 1024 + h * 256 + ch * 8); }
#pragma unroll
                for (int i = 0; i < 2; ++i) { const int id = tid + 512 * i, r = id >> 3, ch = id & 7; vv[i] = *(const u32x4*)(V + (size_t)(rown + r) * 2048 + h * 512 + dvs * 64 + ch * 8); }
            }
            f32x16 acc;
#pragma unroll
            for (int r = 0; r < 16; ++r) acc[r] = 0.f;
            {
                const LAS unsigned char* sb = lds + RS_SOFF + (32 * dvb + l31) * RS_SROW + 16 * h2;
#pragma unroll
                for (int g = 0; g < 2; ++g) {
                    bf16x8 sfr[8];
#pragma unroll
                    for (int f = 0; f < 8; ++f) sfr[f] = *(const LAS bf16x8*)(sb + 32 * (8 * g + f));
                    __builtin_amdgcn_sched_barrier(0);
#pragma unroll
                    for (int f = 0; f < 8; ++f) acc = __builtin_amdgcn_mfma_f32_32x32x16_bf16(qf[8 * g + f], sfr[f], acc, 0, 0, 0);
                    __builtin_amdgcn_sched_barrier(0);
                }
            }
#pragma unroll
            for (int r = 0; r < 16; ++r) {
                const int i = 32 * ib + crow(r, h2), ip = dir ? 127 - i : i;
                acc[r] *= __builtin_amdgcn_exp2f((float)(ip + 1) * lgd);
            }
            {
                const LAS unsigned char* vbase = lds + RS_VOFF + (8 * h2 + trr) * RS_VROW + dvb * 64 + trl;
                bf16x8 vfa[8];
#pragma unroll
                for (int ks = 0; ks < 8; ++ks) vfa[ks] = cat4(vtr(vbase + ks * 16 * RS_VROW), vtr(vbase + (ks * 16 + 4) * RS_VROW));
                __builtin_amdgcn_sched_barrier(0);
#pragma unroll
                for (int ks = 0; ks < 8; ++ks) acc = __builtin_amdgcn_mfma_f32_32x32x16_bf16(pfr[ks], vfa[ks], acc, 0, 0, 0);
                __builtin_amdgcn_sched_barrier(0);
            }
            {
                const bool odd1 = (l31 & 1) != 0, odd2 = (l31 & 2) != 0;
                const unsigned sel1 = odd1 ? 0x03020706u : 0x05040100u;
                unsigned wq[8];
#pragma unroll
                for (int k = 0; k < 8; ++k) {
                    const unsigned pk = cvtpk_v(acc[2 * k], acc[2 * k + 1]);
                    const unsigned qk = (unsigned)__builtin_amdgcn_mov_dpp((int)pk, 0xB1, 0xf, 0xf, false);
                    wq[k] = __builtin_amdgcn_perm(qk, pk, sel1);
                }
#pragma unroll
                for (int j = 0; j < 4; ++j) {
                    const unsigned keep = odd2 ? wq[2 * j + 1] : wq[2 * j], send = odd2 ? wq[2 * j] : wq[2 * j + 1];
                    const unsigned recv = (unsigned)__builtin_amdgcn_mov_dpp((int)send, 0x4E, 0xf, 0xf, false);
                    u32x2 o; o.x = odd2 ? recv : keep; o.y = odd2 ? keep : recv;
                    if (dir == 0) {
                        const float a0 = __uint_as_float(o.x << 16) + __uint_as_float(prev2[j].x << 16), a1 = __uint_as_float(o.x & 0xffff0000u) + __uint_as_float(prev2[j].x & 0xffff0000u);
                        const float a2 = __uint_as_float(o.y << 16) + __uint_as_float(prev2[j].y << 16), a3 = __uint_as_float(o.y & 0xffff0000u) + __uint_as_float(prev2[j].y & 0xffff0000u);
                        o.x = cvt_pk_bf16(a0, a1); o.y = cvt_pk_bf16(a2, a3);
                    }
                    *(u32x2*)(op + (size_t)(8 * j) * 2048) = o;
                }
            }
            {
                const LAS unsigned char* kb = lds + RS_KOFF + (8 * h2 + trr) * RS_KROW + trl + (2 * ib) * 64;
                const LAS unsigned char* vzb = lds + RS_VZOFF + (8 * h2 + trr) * RS_VROW + dvb * 64 + trl;
#pragma unroll
                for (int d = 0; d < 2; ++d)
#pragma unroll
                    for (int r = 0; r < 16; ++r) S[d][r] *= gC;
                bf16x8 uf[2][3];
#define RS_UPD_LOAD(st, ks_) do { uf[st][0] = cat4(vtr(vzb + (ks_) * 16 * RS_VROW), vtr(vzb + ((ks_) * 16 + 4) * RS_VROW)); \
        uf[st][1] = cat4(vtr(kb + (ks_) * 16 * RS_KROW), vtr(kb + ((ks_) * 16 + 4) * RS_KROW)); uf[st][2] = cat4(vtr(kb + (ks_) * 16 * RS_KROW + 64), vtr(kb + ((ks_) * 16 + 4) * RS_KROW + 64)); } while (0)
                RS_UPD_LOAD(0, 0);
#pragma unroll
                for (int ks = 0; ks < 8; ++ks) {
                    if (ks + 1 < 8) RS_UPD_LOAD((ks + 1) & 1, ks + 1);
                    __builtin_amdgcn_sched_barrier(0);
                    S[0] = __builtin_amdgcn_mfma_f32_32x32x16_bf16(uf[ks & 1][1], uf[ks & 1][0], S[0], 0, 0, 0);
                    S[1] = __builtin_amdgcn_mfma_f32_32x32x16_bf16(uf[ks & 1][2], uf[ks & 1][0], S[1], 0, 0, 0);
                    __builtin_amdgcn_sched_barrier(0);
                }
#undef RS_UPD_LOAD
            }
        }
        __builtin_amdgcn_s_waitcnt(0); __syncthreads();
    }
}
#ifndef REP_P0
#define REP_P0 1
#endif
#ifndef REP_C
#define REP_C 1
#endif
#ifndef REP_G24
#define REP_G24 1
#endif
#ifndef REP_GS
#define REP_GS 1
#endif
#ifndef REP_RC
#define REP_RC 1
#endif
#ifndef REP_FIN
#define REP_FIN 1
#endif
#ifndef REP_G
#define REP_G 1
#endif
#ifndef REP_DA
#define REP_DA 1
#endif
#ifndef REP_RS
#define REP_RS 1
#endif
#ifndef REP_SYNC
#define REP_SYNC 1
#endif
#ifndef REP_NA
#define REP_NA 1
#endif
#ifndef REP_N
#define REP_N 1
#endif
#ifndef REP_RP
#define REP_RP 1
#endif
#ifndef EN_G1A
#define EN_G1A 1
#endif
#ifndef EN_G1B
#define EN_G1B 1
#endif
#ifndef EN_G1C
#define EN_G1C 1
#endif
#ifndef EN_DA
#define EN_DA 1
#endif
#ifndef EN_RP
#define EN_RP 1
#endif
#ifndef EN_RS
#define EN_RS 1
#endif
#ifndef EN_NA
#define EN_NA 1
#endif
#ifndef EN_G2
#define EN_G2 1
#endif
#ifndef EN_G3
#define EN_G3 1
#endif
#ifndef EN_G4
#define EN_G4 1
#endif

typedef const __attribute__((address_space(4))) Params* KParams;
__device__ __forceinline__ KParams get_params() { KParams kp = (KParams)__builtin_amdgcn_kernarg_segment_ptr(); asm volatile("" : "+s"(kp)); return kp; }
#define PH_PTRS \
    KParams kp_ = get_params(); const auto& p = *kp_; \
    unsigned char* ws = p.ws; float* XL = p.out; float* XC = (float*)(ws + WS_XC); float* mods = (float*)(ws + WS_MODS); float* tab = (float*)(ws + WS_TAB); float* lgt = tab + 10240; \
    bf16_t* H = (bf16_t*)(ws + WS_H); unsigned char* R = ws + WS_R; \
    (void)XL; (void)XC; (void)mods; (void)tab; (void)lgt; (void)H; (void)R;
#define PH_IDS const int tid = ltid(), lane = tid & 63, wave = __builtin_amdgcn_readfirstlane(tid >> 6); const int G = lgrid(), bid = lbid(), gw = bid * 8 + wave, NGW = G * 8; (void)lane; (void)gw; (void)NGW; (void)bid; (void)G;

__device__ __forceinline__ void ph_prologue(unsigned char* smem) {
    PH_PTRS PH_IDS
    const size_t gt = (size_t)bid * 512 + tid, NT = (size_t)G * 512;
    for (size_t i = gt; i < (size_t)ML * DM / 4; i += NT) ((f32x4*)XL)[i] = ((const f32x4*)p.x)[i];
    for (size_t i = gt; i < (size_t)MC * DM / 4; i += NT) ((f32x4*)XC)[i] = ((const f32x4*)p.ctx)[i];
    for (size_t i = gt; i < 1024 + 4096 + 8; i += NT) {
        if (i < 1024) { const int pos = (int)i >> 4, f = (int)i & 15; const float inv = __builtin_amdgcn_exp2f(-(float)f * (13.287712379549449f / 16.f));
            float a = (float)pos * inv; const float n = rintf(a * 0.15915494309189535f); a = fmaf(-n, 6.2831854820251465f, a); a = fmaf(-n, -1.7484556e-7f, a);
            tab[i] = __cosf(a); tab[1024 + i] = __sinf(a); }
        else if (i < 5120) { const int k = (int)i - 1024, pos = k >> 6, f = k & 63; const float inv = __builtin_amdgcn_exp2f(-(float)f * (13.287712379549449f / 64.f));
            float a = (float)pos * inv; const float n = rintf(a * 0.15915494309189535f); a = fmaf(-n, 6.2831854820251465f, a); a = fmaf(-n, -1.7484556e-7f, a);
            tab[2048 + k] = __cosf(a); tab[2048 + 4096 + k] = __sinf(a); }
        else { const int k = (int)i - 5120; lgt[k] = -log1pf(__expf(-p.ret_decay[k])) * LOG2E; }
    }
    float* cl = (float*)smem;
    float* red = cl + 9 * 1024;
    for (int i = tid; i < 9 * 1024; i += 512) { const float v = i < 8192 ? p.c[i] : p.c_ctx[i - 8192]; cl[i] = silu_f(v); }
    __syncthreads();
    for (int tile = bid; tile < 4 * 96; tile += G) {
        const int li = tile / 96, cb = tile - li * 96, col = cb * 64 + (tid & 63), kq = tid >> 6;
        const float* wp = p.w_ada + (size_t)li * 1024 * 6144 + (size_t)(kq * 128) * 6144 + col;
        float a[9];
#pragma unroll
        for (int m = 0; m < 9; ++m) a[m] = 0.f;
#pragma unroll 4
        for (int k = 0; k < 128; ++k) { const float wv = wp[(size_t)k * 6144];
#pragma unroll
            for (int m = 0; m < 9; ++m) a[m] += cl[m * 1024 + kq * 128 + k] * wv; }
#pragma unroll
        for (int m = 0; m < 9; ++m) red[(kq * 9 + m) * 64 + (tid & 63)] = a[m];
        __syncthreads();
        for (int o = tid; o < 9 * 64; o += 512) { const int m = o >> 6, cc = o & 63; float s = 0.f;
#pragma unroll
            for (int q = 0; q < 8; ++q) s += red[(q * 9 + m) * 64 + cc];
            mods[(size_t)(li * 9 + m) * 6144 + cb * 64 + cc] = s + p.b_ada[li * 6144 + cb * 64 + cc]; }
        __syncthreads();
    }
}
__device__ __forceinline__ void ph_cvt_norm1(unsigned char* smem, int li) {
    PH_PTRS PH_IDS
    const int kind = li % 3; const float* md = mods + (size_t)li * 9 * 6144;
    bf16_t *Wqkv = (bf16_t*)(ws + WS_WQKV), *Wo = (bf16_t*)(ws + WS_WO), *Wf1 = (bf16_t*)(ws + WS_WF1), *Wf2 = (bf16_t*)(ws + WS_WF2);
    float* scr = (float*)smem + wave * (64 * 33);
    const float *wq, *wo; int nq, ko, lim, grp, P;
    if (kind == 0) { const int ia = li / 3; wq = p.da_w_qkv + (size_t)ia * 1024 * 3072; wo = p.da_w_o + (size_t)ia * 1024 * 1024; nq = 3072; ko = 1024; lim = 2048; grp = 64; P = 32; }
    else if (kind == 1) { wq = p.ret_w_in; wo = p.ret_w_o; nq = 6144; ko = 2048; lim = 2048; grp = 256; P = 128; }
    else { wq = p.na_w_qkv; wo = p.na_w_o; nq = 3072; ko = 1024; lim = 0; grp = 64; P = 32; }
    const int I1 = 16 * (nq / 32), I2 = (ko / 64) * 32, I3 = 16 * (5632 / 32), I4 = 44 * 32;
    for (int it = gw; it < I1 + I2 + I3 + I4; it += NGW) {
        int r = it;
        if (r < I1) { cvt_item(wq, 1024, nq, Wqkv, scr, r, lane, lim, grp, P); continue; } r -= I1;
        if (r < I2) { cvt_item(wo, ko, 1024, Wo, scr, r, lane, 0, 64, 32); continue; } r -= I2;
        if (r < I3) { cvt_item(p.ffn_in + (size_t)li * 1024 * 5632, 1024, 5632, Wf1, scr, r, lane, 5632, 5632, 2816); continue; } r -= I3;
        cvt_item(p.ffn_out + (size_t)li * 2816 * 1024, 2816, 1024, Wf2, scr, r, lane, 0, 64, 32);
    }
    const float* g1 = p.norm_g + (size_t)(li * 2) * 1024;
    for (int row = gw; row < MT; row += NGW) {
        const int mi = row < ML ? row >> 11 : 8;
        if (row < ML || li == 0) { float* xr = row < ML ? XL + (size_t)row * DM : XC + (size_t)(row - ML) * DM; mod_row<0>(xr, nullptr, g1, md + mi * 6144, md + mi * 6144 + 1024, H + (size_t)row * DM, lane); }
        else mod_row<4>(XC + (size_t)(row - ML) * DM, (const float*)(R + 108 * MiB) + (size_t)(row - ML) * DM, g1, md + mi * 6144, md + mi * 6144 + 1024, H + (size_t)row * DM, lane);
    }
}
__device__ __forceinline__ void ph_norm2(int li) {
    PH_PTRS PH_IDS
    const float* md = mods + (size_t)li * 9 * 6144; const int MR = li < 3 ? MT : ML;
    const float* g2 = p.norm_g + (size_t)(li * 2 + 1) * 1024;
    for (int row = gw; row < MR; row += NGW) {
        const int mi = row < ML ? row >> 11 : 8;
        if (row < ML) mod_row<0>(XL + (size_t)row * DM, nullptr, g2, md + mi * 6144 + 3 * 1024, md + mi * 6144 + 4 * 1024, H + (size_t)row * DM, lane);
        else mod_row<4>(XC + (size_t)(row - ML) * DM, (const float*)(R + 36 * MiB) + (size_t)(row - ML) * DM, g2, md + mi * 6144 + 3 * 1024, md + mi * 6144 + 4 * 1024, H + (size_t)row * DM, lane);
    }
}
__device__ __forceinline__ void ph_da_attn(unsigned char* smem, int li) {
    PH_PTRS PH_IDS
    const bf16_t *Q = (const bf16_t*)R, *K = (const bf16_t*)(R + 36 * MiB), *V = (const bf16_t*)(R + 72 * MiB); bf16_t* O = (bf16_t*)(R + 108 * MiB);
    const int ia = li / 3; const float lam_init = li == 0 ? 0.2f : 0.55605802f;
    const float* lp = p.da_lambda + ia * 256;
    const float lam = expf(wave_sum(lp[lane] * lp[64 + lane], lane)) - expf(wave_sum(lp[128 + lane] * lp[192 + lane], lane)) + lam_init;
    const float* sg = p.da_subln + ia * 128;
    const int nun = 1024 + (li < 3 ? 128 : 0);
    const int mapw = wave >> 2, qw = wave & 3;
    for (int u = bid; u < nun; u += G) {
        int b, h, q0, nlat;
        if (u < 1024) { const int x = u & 7, s = (u & 255) >> 3 | (u >> 8) << 5, combo = x + 8 * (s >> 4); b = combo >> 3; h = combo & 7; q0 = b * SEQL + (s & 15) * 128; nlat = 32; }
        else { const int v = u - 1024; b = v >> 4; h = (v >> 1) & 7; q0 = ML + b * CTXL + (v & 1) * 128; nlat = 0; }
        q0 += qw * 32;
        flash_unit<128, false, true>(smem, Q + (size_t)q0 * 1024 + (2 * h + mapw) * 64, K + h * 128, V + h * 128, nlat, b * SEQL, 4, ML + b * CTXL, 0, 0, 0, nullptr,
                                     O + (size_t)q0 * 1024 + h * 128, lam, 1.f - lam_init, sg);
    }
}
__device__ __forceinline__ void ph_da_combine(int li) {
    PH_PTRS PH_IDS
    float* OM = (float*)(R + 108 * MiB); bf16_t* O = (bf16_t*)R; const int MR = li < 3 ? MT : ML;
    const int ia = li / 3; const float lam_init = li == 0 ? 0.2f : 0.55605802f;
    const float* lp = p.da_lambda + ia * 256;
    const float lam = expf(wave_sum(lp[lane] * lp[64 + lane], lane)) - expf(wave_sum(lp[128 + lane] * lp[192 + lane], lane)) + lam_init;
    const int hh = lane >> 3, d0 = (lane & 7) * 16;
    const float* sg = p.da_subln + ia * 128 + d0;
    for (int row = gw; row < MR; row += NGW) {
        const float* a = OM + (size_t)row * 2048 + hh * 256 + d0;
        f32x4 o[4]; float ss = 0.f;
#pragma unroll
        for (int j = 0; j < 4; ++j) { o[j] = *(const f32x4*)(a + 4 * j) - *(const f32x4*)(a + 128 + 4 * j) * lam; ss += (o[j].x * o[j].x + o[j].y * o[j].y) + (o[j].z * o[j].z + o[j].w * o[j].w); }
        ss += shx(ss, 1, lane); ss += shx(ss, 2, lane); ss += shx(ss, 4, lane);
        const float rstd = rsqrtf(ss * (1.f / 128.f) + EPSV) * (1.f - lam_init);
        u32x4 w0, w1;
        { const f32x4 g0 = *(const f32x4*)sg, g1 = *(const f32x4*)(sg + 4), g2 = *(const f32x4*)(sg + 8), g3 = *(const f32x4*)(sg + 12);
          const f32x4 a0 = o[0] * rstd * g0, a1 = o[1] * rstd * g1, a2 = o[2] * rstd * g2, a3 = o[3] * rstd * g3;
          w0.x = cvt_pk_bf16(a0.x, a0.y); w0.y = cvt_pk_bf16(a0.z, a0.w); w0.z = cvt_pk_bf16(a1.x, a1.y); w0.w = cvt_pk_bf16(a1.z, a1.w);
          w1.x = cvt_pk_bf16(a2.x, a2.y); w1.y = cvt_pk_bf16(a2.z, a2.w); w1.z = cvt_pk_bf16(a3.x, a3.y); w1.w = cvt_pk_bf16(a3.z, a3.w); }
        bf16_t* op = O + (size_t)row * 1024 + hh * 128 + d0;
        *(u32x4*)op = w0; *(u32x4*)(op + 8) = w1;
    }
}
__device__ __forceinline__ void ph_ret_p() {
    PH_PTRS PH_IDS
    const bf16_t *Q = (const bf16_t*)R, *K = (const bf16_t*)(R + 36 * MiB); bf16_t* Pt = H;
    for (int u = bid; u < 576; u += G) { const int b = u / 72, r = u - b * 72, h = r / 18, ci = r - h * 18; ret_p_unit(Q, K, Pt, b, h, ci, lgt[h], lgt[4 + h]); }
}
__device__ __forceinline__ void ph_ret_scan(unsigned char* smem) {
    PH_PTRS PH_IDS
    const bf16_t *Q = (const bf16_t*)R, *K = (const bf16_t*)(R + 36 * MiB), *V = (const bf16_t*)(R + 72 * MiB); bf16_t* OX = (bf16_t*)(R + 216 * MiB); bf16_t* Pt = H;
    for (int u = bid; u < 256; u += G) { const int x = u & 7, j = u >> 3, combo = x * 4 + (j >> 3), b = combo >> 2, h = combo & 3, dvs = j & 7;
        ret_scan_unit(smem, Q, K, V, Pt, OX, b, h, dvs, lgt); }
}
__device__ __forceinline__ void ph_ret_combine() {
    PH_PTRS PH_IDS
    bf16_t* Gt = (bf16_t*)(R + 144 * MiB); bf16_t* OX = (bf16_t*)(R + 216 * MiB);
    for (int row = gw; row < MT; row += NGW) {
        const bf16_t* ox = OX + (size_t)row * 2048 + lane * 32; bf16_t* gp = Gt + (size_t)row * 2048 + lane * 32;
        u32x4 v[4]; float ss = 0.f;
#pragma unroll
        for (int j = 0; j < 4; ++j) { v[j] = *(const u32x4*)(ox + 8 * j);
#pragma unroll
            for (int e = 0; e < 4; ++e) { const float a = __uint_as_float(v[j][e] << 16), b2 = __uint_as_float(v[j][e] & 0xffff0000u); ss += a * a + b2 * b2; } }
        ss += shx(ss, 1, lane); ss += shx(ss, 2, lane); ss += shx(ss, 4, lane); ss += shx(ss, 8, lane);
        const float rstd = rsqrtf(ss * (1.f / 512.f) + EPSV);
#pragma unroll
        for (int j = 0; j < 4; ++j) { const u32x4 g = *(const u32x4*)(gp + 8 * j); u32x4 o;
#pragma unroll
            for (int e = 0; e < 4; ++e) { const float a = __uint_as_float(v[j][e] << 16) * rstd * __uint_as_float(g[e] << 16), b2 = __uint_as_float(v[j][e] & 0xffff0000u) * rstd * __uint_as_float(g[e] & 0xffff0000u); o[e] = cvt_pk_bf16(a, b2); }
            *(u32x4*)(gp + 8 * j) = o; }
    }
}
__device__ __forceinline__ void ph_na(unsigned char* smem) {
    PH_PTRS PH_IDS
    const bf16_t *Q = (const bf16_t*)R, *K = (const bf16_t*)(R + 36 * MiB), *V = (const bf16_t*)(R + 72 * MiB); bf16_t* O = (bf16_t*)(R + 108 * MiB);
    float* rpbL = (float*)(smem + FaCfg<64>::RPB);
    for (int u = bid; u < 1024 + 128; u += G) {
        if (u < 1024) { const int x = u & 7, s = (u & 255) >> 3 | (u >> 8) << 5, combo = x + 8 * (s >> 3), b = combo >> 4, h = combo & 15, r4 = s & 7;
            for (int i = tid; i < 465; i += 512) rpbL[(i / 31) * 32 + (i % 31)] = p.na_rpb[h * 465 + i];
            int lo = 4 * r4 - 4; lo = lo < 0 ? 0 : (lo > 24 ? 24 : lo); int hi = 4 * r4 + 3 - 4; hi = (hi < 0 ? 0 : (hi > 24 ? 24 : hi)) + 7;
            const int qr = 4 * r4 + (wave >> 1), c0 = 32 * (wave & 1); const int q0 = b * SEQL + qr * 64 + c0;
            flash_unit<64, true>(smem, Q + (size_t)q0 * 1024 + h * 64, K + h * 64, V + h * 64, hi - lo + 1, b * SEQL + 64 * lo, 4, ML + b * CTXL, lo, qr, c0, nullptr, O + (size_t)q0 * 1024 + h * 64); }
        else { const int v = u - 1024, b = v >> 4, h = v & 15; const int q0 = ML + b * CTXL + wave * 32;
            flash_unit<64, false>(smem, Q + (size_t)q0 * 1024 + h * 64, K + h * 64, V + h * 64, 0, 0, 4, ML + b * CTXL, 0, 0, 0, nullptr, O + (size_t)q0 * 1024 + h * 64); }
    }
}
__device__ __forceinline__ void ph_final() {
    PH_PTRS PH_IDS
    for (int row = gw; row < ML; row += NGW) {
        float* xr = XL + (size_t)row * DM; f32x4 v[4]; float s = 0.f;
#pragma unroll
        for (int j = 0; j < 4; ++j) { v[j] = *(const f32x4*)(xr + 4 * lane + 256 * j); s += (v[j].x * v[j].x + v[j].y * v[j].y) + (v[j].z * v[j].z + v[j].w * v[j].w); }
        const float rstd = rsqrtf(wave_sum(s, lane) * (1.f / DM) + EPSV);
#pragma unroll
        for (int j = 0; j < 4; ++j) *(f32x4*)(xr + 4 * lane + 256 * j) = v[j] * rstd * *(const f32x4*)(p.final_g + 4 * lane + 256 * j);
    }
}

__global__ void __launch_bounds__(512, 2) trunk_fwd(Params p) {
    extern __shared__ __attribute__((aligned(16))) unsigned char smem[];
    cg::grid_group grid = cg::this_grid();
    volatile LAS unsigned* bst = (volatile LAS unsigned*)((LAS unsigned char*)smem + LDS_BYTES - 64);
    if (threadIdx.x < 16) bst[threadIdx.x] = 0u;
    __syncthreads();
    XcdBarrier xbar = xcd_barrier_post((unsigned*)(p.ws + WS_BAR), bst);
    for (int rep = 0; rep < REP_GS; ++rep) grid.sync();
    for (int ph = 0; ph < 38; ++ph) {
        LAS unsigned char* lds = (LAS unsigned char*)smem;
        KParams kp_ = get_params(); unsigned char* ws = kp_->ws; float* outp = kp_->out;
        bool did = true;
        if (ph == 0) { for (int rep = 0; rep < REP_P0; ++rep) { __syncthreads(); ph_prologue(smem); } }
        else if (ph == 37) { for (int rep = 0; rep < REP_FIN; ++rep) ph_final(); }
        else {
            const int li = (ph - 1) / 9, sl = (ph - 1) - li * 9, kind = li % 3;
            const int MR = li < 3 ? MT : ML;
            float* mods = (float*)(ws + WS_MODS); const float* md = mods + (size_t)li * 9 * 6144;
            bf16_t* H = (bf16_t*)(ws + WS_H); unsigned char* R = ws + WS_R; float* tab = (float*)(ws + WS_TAB);
            switch (sl) {
            case 0: for (int rep = 0; rep < REP_N; ++rep) { __syncthreads(); ph_cvt_norm1(smem, li); } break;
            case 1:
              for (int rep = 0; rep < REP_G; ++rep) {
#if EN_G1A
                if (kind == 0) { EpiQKV<0> E{R, tab}; run_gemm<3072, 1024>(lds, H, (const bf16_t*)(ws + WS_WQKV), MT, E); }
#endif
#if EN_G1B
                if (kind == 1) { EpiQKV<2> E{R, tab}; run_gemm<6144, 1024>(lds, H, (const bf16_t*)(ws + WS_WQKV), MT, E); }
#endif
#if EN_G1C
                if (kind == 2) { EpiQKV<1> E{R, tab}; run_gemm<3072, 1024>(lds, H, (const bf16_t*)(ws + WS_WQKV), MT, E); }
#endif
              }
                break;
            case 2:
#if EN_DA
                if (kind == 0) for (int rep = 0; rep < REP_DA; ++rep) ph_da_attn(smem, li);
#endif
#if EN_RP
                if (kind == 1) for (int rep = 0; rep < REP_RP; ++rep) ph_ret_p();
#endif
#if EN_NA
                if (kind == 2) for (int rep = 0; rep < REP_NA; ++rep) ph_na(smem);
#endif
                break;
            case 3:
                if (kind == 0) did = false;
#if EN_RS
                else if (kind == 1) for (int rep = 0; rep < REP_RS; ++rep) ph_ret_scan(smem);
#endif
                else did = false;
                break;
            case 4:
                if (kind == 1) { for (int rep = 0; rep < REP_RC; ++rep) ph_ret_combine(); } else did = false;
                break;
            case 5: {
#if EN_G2
              for (int rep = 0; rep < REP_G24; ++rep) {
                const float gs_ = rep == REP_G24 - 1 ? 1.f : 0.f;
                if (kind == 1) { EpiRes<32> E{outp, (float*)(ws + WS_XC), md + 2 * 1024, gs_, (float*)(R + 36 * MiB)}; run_gemm_res<2048, 4>(lds, (const bf16_t*)(R + 144 * MiB), (const bf16_t*)(ws + WS_WO), MR, E); }
                else { EpiRes<16> E{outp, (float*)(ws + WS_XC), md + 2 * 1024, gs_, (float*)(R + 36 * MiB)}; run_gemm_res<1024, 4>(lds, (const bf16_t*)(R + 108 * MiB), (const bf16_t*)(ws + WS_WO), MR, E); }
              }
#endif
                break; }
            case 6: for (int rep = 0; rep < REP_N; ++rep) ph_norm2(li); break;
            case 7: {
#if EN_G3
                EpiSwiglu E{(bf16_t*)R}; for (int rep = 0; rep < REP_G; ++rep) run_gemm<5632, 1024>(lds, H, (const bf16_t*)(ws + WS_WF1), MR, E);
#endif
                break; }
            default: {
#if EN_G4
                for (int rep = 0; rep < REP_G24; ++rep) { EpiRes<44> E{outp, (float*)(ws + WS_XC), md + 5 * 1024, rep == REP_G24 - 1 ? 1.f : 0.f, (float*)(R + 108 * MiB)}; run_gemm_res<2816, 4>(lds, (const bf16_t*)R, (const bf16_t*)(ws + WS_WF2), MR, E); }
#endif
                break; }
            }
        }
        if (did) for (int rep = 0; rep < REP_SYNC; ++rep) xcd_barrier(xbar);
    }
}

extern "C" void kernel_launch(void* const* d_in, const int* in_sizes, int n_in, void* d_out, int out_size, void* d_ws, size_t ws_size, hipStream_t stream) {
    static int grid_blocks = 0;
    if (!grid_blocks) {
        int dev = 0, cus = 0, per_cu = 0;
        (void)hipGetDevice(&dev);
        (void)hipDeviceGetAttribute(&cus, hipDeviceAttributeMultiprocessorCount, dev);
        (void)hipFuncSetAttribute((const void*)trunk_fwd, hipFuncAttributeMaxDynamicSharedMemorySize, LDS_BYTES);
        (void)hipOccupancyMaxActiveBlocksPerMultiprocessor(&per_cu, (const void*)trunk_fwd, 512, LDS_BYTES);
        grid_blocks = cus > 0 ? cus : 256;
        fprintf(stderr, "kernel_launch: cus=%d per_cu=%d ws=%zu n_in=%d\n", cus, per_cu, ws_size, n_in);
        if (ws_size < WS_NEED || n_in != 20) { fprintf(stderr, "kernel_launch: workspace too small or wrong input count\n"); grid_blocks = -1; }
    }
    if (grid_blocks < 0) return;
    (void)hipMemsetAsync((unsigned char*)d_ws + WS_BAR, 0, 16384, stream);
    Params p{};
    const float** pp = (const float**)&p;
    for (int i = 0; i < 20; ++i) pp[i] = (const float*)d_in[i];
    p.out = (float*)d_out; p.ws = (unsigned char*)d_ws;
    void* args[] = {&p};
    hipError_t e = hipLaunchCooperativeKernel((const void*)trunk_fwd, dim3(grid_blocks), dim3(512), args, LDS_BYTES, stream);
    if (e != hipSuccess) fprintf(stderr, "cooperative launch failed: %s\n", hipGetErrorString(e));
}
```

```cpp
#include <hip/hip_runtime.h>
#include <hip/hip_cooperative_groups.h>
#include <cstdio>
#include <cstdint>
namespace cg = cooperative_groups;
__device__ __forceinline__ int ltid() { int t = threadIdx.x; asm volatile("" : "+v"(t)); return t; }
__device__ __forceinline__ int lbid() { int t = blockIdx.x; asm volatile("" : "+s"(t)); return t; }
__device__ __forceinline__ int lgrid() { int t = gridDim.x; asm volatile("" : "+s"(t)); return t; }
namespace pg8 {
#define PG8_LAS __attribute__((address_space(3)))
typedef unsigned short bf16_t;
typedef short bf16x8 __attribute__((ext_vector_type(8)));
typedef float f32x4 __attribute__((ext_vector_type(4)));
typedef unsigned u32x4 __attribute__((ext_vector_type(4)));
constexpr int BM = 256, BK = 64, HALF = 128, HTB = HALF * BK * 2  , STAGE_BYTES = 8 * HTB, NXCD = 8, WGM = 8;

__host__ __device__ __forceinline__ int lds_byte(int r, int c) { const int st = (r >> 4) * 2 + (c >> 5), rr = r & 15, cc = c & 31, ob = rr * 64 + cc * 2; return st * 1024 + (ob ^ (((ob >> 9) & 1) << 5)); }
__host__ __device__ __forceinline__ void stage_rc(int b, int& R, int& C) { const int st = b / 1024, sb = b % 1024, swz = sb ^ (((sb >> 9) & 1) << 5); R = (st >> 1) * 16 + swz / 64; C = (st & 1) * 32 + (swz % 64) / 2; }
__host__ __device__ __forceinline__ int perm32(int rho) { const int n = rho >> 4, i = rho & 15; return 8 * (i >> 2) + 4 * n + (i & 3); }

struct Unit { int pm, pn, k0, nt, part; };
struct Gemm { const bf16_t* A; const bf16_t* Bt; int M, N, K; };

struct StaticOrder {
    int nM, nN, nwg, G, c;
    __host__ __device__ void init(int M, int N, int G_, int c_) { nM = M / BM; nN = N / BM; nwg = nM * nN; G = G_; c = c_; }
    __host__ __device__ bool next(int i, Unit& u) const {
        const long L = (long)i * G + c; if (L >= nwg) return false;
        int wgid = (int)L; { const int q = nwg / NXCD, r = nwg % NXCD, xcd = wgid % NXCD, off = wgid / NXCD; wgid = (xcd < r ? xcd * (q + 1) : r * (q + 1) + (xcd - r) * q) + off; }
        const int nig = WGM * nN, gid = wgid / nig, fm = gid * WGM, gsz = (nM - fm) < WGM ? (nM - fm) : WGM;
        u.pm = fm + ((wgid % nig) % gsz); u.pn = (wgid % nig) / gsz; return true;
    }
    __device__ __forceinline__ void a_ready(const Unit&) const {}
    __device__ __forceinline__ void done(const Unit&) const {}
};

__device__ __forceinline__ unsigned cvt_pk_bf16(float lo, float hi) { unsigned r; asm volatile("v_cvt_pk_bf16_f32 %0, %1, %2" : "=v"(r) : "v"(lo), "v"(hi)); return r; }
typedef float f32x2 __attribute__((ext_vector_type(2)));
template <class Epi, class Sched, bool ALIGN_EPI = false, bool SP2 = false>
__device__ __forceinline__ void gemm_phase(PG8_LAS unsigned char* lds, const Gemm g, const Sched& S, const Epi& E) {
    const int tid = ltid(), wid = __builtin_amdgcn_readfirstlane(tid >> 6), lane = tid & 63, wr = wid >> 2, wc = wid & 3, fr = lane & 15, fq = lane >> 4;
    const int K = g.K;
    unsigned voffA[2], voffB[2];
#pragma unroll
    for (int i = 0; i < 2; ++i) { int R, C; stage_rc(tid * 16 + i * 8192, R, C); const int Rb = Epi::PERM ? ((R & ~31) + perm32(R & 31)) : R;
        voffA[i] = (unsigned)(R * K + C) * 2u; voffB[i] = (unsigned)(Rb * K + C) * 2u; }
    const size_t kstep = (size_t)(BK * 2);
    const size_t hstep = (size_t)HALF * K * 2;
    const size_t tstep = 2 * hstep;
    const unsigned ldsw = (unsigned)wid * 1024u;
    const int aoff = lds_byte(wr * 64 + fr, fq * 8), boff = lds_byte(wc * 32 + fr, fq * 8);
#define PG8_SA(b, h) (((b) * 2 + (h)) * HTB)
#define PG8_SB(b, h) ((4 + (b) * 2 + (h)) * HTB)
#define PG8_STAGE(bufoff, gbase, voff) do { _Pragma("unroll") for (int _i = 0; _i < 2; ++_i) \
        __builtin_amdgcn_global_load_lds((const unsigned*)((const char*)(gbase) + (voff)[_i]), (PG8_LAS unsigned*)(lds + (bufoff) + ldsw + _i * 8192), 16, 0, 0); } while (0)
#define PG8_LDA(dst, b, h) do { _Pragma("unroll") for (int m = 0; m < 4; ++m) _Pragma("unroll") for (int k = 0; k < 2; ++k) dst[m][k] = *(const PG8_LAS bf16x8*)(lds + PG8_SA(b, h) + aoff + m * 2048 + k * 1024); } while (0)
#define PG8_LDB(dst, b, h) do { _Pragma("unroll") for (int n = 0; n < 2; ++n) _Pragma("unroll") for (int k = 0; k < 2; ++k) dst[n][k] = *(const PG8_LAS bf16x8*)(lds + PG8_SB(b, h) + boff + n * 2048 + k * 1024); } while (0)
#define PG8_MMA(ai, bj, At, Bt) do { __builtin_amdgcn_s_setprio(1); _Pragma("unroll") for (int m = 0; m < 4; ++m) _Pragma("unroll") for (int n = 0; n < 2; ++n) _Pragma("unroll") for (int k = 0; k < 2; ++k) \
        acc[ai][bj][m][n] = __builtin_amdgcn_mfma_f32_16x16x32_bf16(Bt[n][k], At[m][k], acc[ai][bj][m][n], 0, 0, 0); __builtin_amdgcn_s_setprio(0); } while (0)
#define PG8_WAIT_V(n) asm volatile("s_waitcnt vmcnt(" #n ")" ::: "memory")
#define PG8_WAIT_L(n) asm volatile("s_waitcnt lgkmcnt(" #n ")" ::: "memory")
#define PG8_BAR __builtin_amdgcn_s_barrier()
#define PG8_SCHED __builtin_amdgcn_sched_barrier(0)
    Unit cur, nxt; int ui = 0;
    if (!S.next(0, cur)) return;
    f32x4 acc[2][2][4][2];
#pragma unroll
    for (int a = 0; a < 2; ++a)
#pragma unroll
        for (int b = 0; b < 2; ++b)
#pragma unroll
            for (int m = 0; m < 4; ++m)
#pragma unroll
                for (int n = 0; n < 2; ++n) acc[a][b][m][n] = (f32x4){0.f, 0.f, 0.f, 0.f};
    bf16x8 At[4][2], B0[2][2], B1[2][2];
    const char* cA = (const char*)g.A + (size_t)cur.pm * tstep + (size_t)cur.k0 * 2; const char* cB = (const char*)g.Bt + (size_t)cur.pn * tstep + (size_t)cur.k0 * 2;
    S.a_ready(cur);
    if constexpr (SP2) {
        PG8_STAGE(PG8_SB(0, 0), cB, voffB); PG8_STAGE(PG8_SB(0, 1), cB + hstep, voffB); PG8_STAGE(PG8_SA(0, 0), cA, voffA); PG8_STAGE(PG8_SA(0, 1), cA + hstep, voffA);
        if (wr == 1) PG8_BAR;
        PG8_WAIT_V(2); PG8_BAR;
        PG8_STAGE(PG8_SB(1, 0), cB + kstep, voffB); PG8_STAGE(PG8_SA(1, 0), cA + kstep, voffA); PG8_STAGE(PG8_SB(1, 1), cB + hstep + kstep, voffB);
        PG8_WAIT_V(6); PG8_BAR;
    } else {
        PG8_STAGE(PG8_SB(0, 0), cB, voffB); PG8_STAGE(PG8_SA(0, 0), cA, voffA); PG8_STAGE(PG8_SB(0, 1), cB + hstep, voffB); PG8_STAGE(PG8_SA(0, 1), cA + hstep, voffA);
        if (wr == 1) PG8_BAR;
        PG8_WAIT_V(4); PG8_BAR;
        PG8_STAGE(PG8_SB(1, 0), cB + kstep, voffB); PG8_STAGE(PG8_SA(1, 0), cA + kstep, voffA); PG8_STAGE(PG8_SB(1, 1), cB + hstep + kstep, voffB);
        PG8_WAIT_V(6); PG8_BAR;
    }
    for (;;) {
        const bool has_next = S.next(ui + 1, nxt);
        const char* nA = has_next ? (const char*)g.A + (size_t)nxt.pm * tstep + (size_t)nxt.k0 * 2 : cA; const char* nB = has_next ? (const char*)g.Bt + (size_t)nxt.pn * tstep + (size_t)nxt.k0 * 2 : cB;
        const int nt = cur.nt;
        for (int t = 0; t < nt; t += 2) {
            const bool last = (t == nt - 2);
            const char* a1 = cA + (size_t)(t + 1) * kstep;
            const char* a2 = last ? nA : cA + (size_t)(t + 2) * kstep; const char* b2 = last ? nB : cB + (size_t)(t + 2) * kstep;
            const char* a3 = a2 + kstep; const char* b3 = b2 + kstep;
            if (last && has_next) S.a_ready(nxt);
            if constexpr (SP2) {
            PG8_LDB(B0, 0, 0); PG8_LDB(B1, 0, 1); PG8_SCHED; PG8_LDA(At, 0, 0); PG8_STAGE(PG8_SA(1, 1), a1 + hstep, voffA);
            PG8_WAIT_V(8); PG8_WAIT_L(0); PG8_BAR; PG8_MMA(0, 0, At, B0); PG8_MMA(0, 1, At, B1); PG8_BAR; PG8_SCHED;
            PG8_LDA(At, 0, 1); PG8_STAGE(PG8_SB(0, 0), b2, voffB); PG8_STAGE(PG8_SB(0, 1), b2 + hstep, voffB); PG8_STAGE(PG8_SA(0, 0), a2, voffA);
            PG8_WAIT_V(8); PG8_WAIT_L(0); PG8_BAR; PG8_MMA(1, 0, At, B0); PG8_MMA(1, 1, At, B1); PG8_BAR; PG8_SCHED;
            PG8_LDB(B0, 1, 0); PG8_LDB(B1, 1, 1); PG8_SCHED; PG8_LDA(At, 1, 0); PG8_STAGE(PG8_SA(0, 1), a2 + hstep, voffA);
            PG8_WAIT_V(8); PG8_WAIT_L(0); PG8_BAR; PG8_MMA(0, 0, At, B0); PG8_MMA(0, 1, At, B1); PG8_BAR; PG8_SCHED;
            PG8_LDA(At, 1, 1); PG8_STAGE(PG8_SB(1, 0), b3, voffB); PG8_STAGE(PG8_SB(1, 1), b3 + hstep, voffB); PG8_STAGE(PG8_SA(1, 0), a3, voffA);
            PG8_WAIT_V(8); PG8_WAIT_L(0); PG8_BAR; PG8_MMA(1, 0, At, B0); PG8_MMA(1, 1, At, B1); PG8_BAR; PG8_SCHED;
            } else {
            PG8_LDB(B0, 0, 0); PG8_SCHED; PG8_LDA(At, 0, 0); PG8_STAGE(PG8_SA(1, 1), a1 + hstep, voffA);
            PG8_WAIT_L(8); PG8_BAR; PG8_WAIT_L(0); PG8_MMA(0, 0, At, B0); PG8_BAR; PG8_SCHED;
            PG8_LDB(B1, 0, 1); PG8_STAGE(PG8_SB(0, 0), b2, voffB);
            PG8_BAR; PG8_WAIT_L(0); PG8_MMA(0, 1, At, B1); PG8_BAR;
            PG8_LDA(At, 0, 1); PG8_STAGE(PG8_SA(0, 0), a2, voffA);
            PG8_BAR; PG8_WAIT_L(0); PG8_MMA(1, 0, At, B0); PG8_BAR; PG8_SCHED;
            PG8_STAGE(PG8_SB(0, 1), b2 + hstep, voffB);
            PG8_WAIT_V(6); PG8_BAR; PG8_MMA(1, 1, At, B1); PG8_BAR;
            PG8_LDB(B0, 1, 0); PG8_SCHED; PG8_LDA(At, 1, 0); PG8_STAGE(PG8_SA(0, 1), a2 + hstep, voffA);
            PG8_WAIT_L(8); PG8_BAR; PG8_WAIT_L(0); PG8_MMA(0, 0, At, B0); PG8_BAR; PG8_SCHED;
            PG8_LDB(B1, 1, 1); PG8_STAGE(PG8_SB(1, 0), b3, voffB);
            PG8_BAR; PG8_WAIT_L(0); PG8_MMA(0, 1, At, B1); PG8_BAR;
            PG8_LDA(At, 1, 1); PG8_STAGE(PG8_SA(1, 0), a3, voffA);
            PG8_BAR; PG8_WAIT_L(0); PG8_MMA(1, 0, At, B0); PG8_BAR; PG8_SCHED;
            PG8_STAGE(PG8_SB(1, 1), b3 + hstep, voffB);
            PG8_WAIT_V(6); PG8_BAR; PG8_MMA(1, 1, At, B1); PG8_BAR;
            }
        }
        if constexpr (ALIGN_EPI) { if (wr == 0) PG8_BAR; }
        if constexpr (!Epi::AFTER_DRAIN) { E(acc, cur, wr, wc, fr, fq); S.done(cur); }
        if (!has_next) break;
#pragma unroll
        for (int a = 0; a < 2; ++a)
#pragma unroll
            for (int b = 0; b < 2; ++b)
#pragma unroll
                for (int m = 0; m < 4; ++m)
#pragma unroll
                    for (int n = 0; n < 2; ++n) acc[a][b][m][n] = (f32x4){0.f, 0.f, 0.f, 0.f};
        cur = nxt; cA = nA; cB = nB; ++ui;
        if constexpr (ALIGN_EPI) { if (wr == 1) PG8_BAR; }
    }
    PG8_WAIT_V(0);
    if constexpr (!ALIGN_EPI) { if (wr == 0) PG8_BAR; }
    PG8_BAR;
    if constexpr (Epi::AFTER_DRAIN) { E.fused(acc, cur, wr, wc, fr, fq, lds, wid, lane); S.done(cur); }
#undef PG8_SA
#undef PG8_SB
#undef PG8_STAGE
#undef PG8_LDA
#undef PG8_LDB
#undef PG8_MMA
#undef PG8_WAIT_V
#undef PG8_WAIT_L
#undef PG8_BAR
#undef PG8_SCHED
}
}
#define LAS __attribute__((address_space(3)))
typedef unsigned short bf16_t;
typedef short bf16x8 __attribute__((ext_vector_type(8)));
typedef short s16x4 __attribute__((ext_vector_type(4)));
typedef float f32x4 __attribute__((ext_vector_type(4)));
typedef float f32x16 __attribute__((ext_vector_type(16)));
typedef unsigned u32x4 __attribute__((ext_vector_type(4)));
typedef unsigned u32x2 __attribute__((ext_vector_type(2)));
using pg8::cvt_pk_bf16;

constexpr int DM = 1024, NB = 8, SEQL = 2048, CTXL = 256, ML = NB * SEQL, MC = NB * CTXL, MT = ML + MC, FFH = 2816;
constexpr float EPSV = 1e-6f, LOG2E = 1.4426950408889634f, C2S = 0.125f * 1.4426950408889634f;
constexpr size_t MiB = 1u << 20;
constexpr size_t WS_WQKV = 0, WS_WO = 12 * MiB, WS_WF1 = 16 * MiB, WS_WF2 = 27 * MiB;
constexpr size_t WS_XC = 34 * MiB, WS_MODS = 42 * MiB, WS_TAB = 43 * MiB, WS_H = 44 * MiB, WS_R = 80 * MiB;
constexpr size_t WS_NEED = 368 * MiB;
constexpr size_t WS_BAR = WS_TAB + 512 * 1024;
constexpr int LDS_BYTES = 160 * 1024;

struct Params {
    const float *x, *c, *ctx, *c_ctx, *w_ada, *b_ada, *norm_g, *ffn_in, *ffn_out, *final_g, *da_w_qkv, *da_w_o, *da_lambda, *da_subln,
        *ret_w_in, *ret_w_o, *ret_decay, *na_w_qkv, *na_w_o, *na_rpb;
    float* out; unsigned char* ws;
};

__device__ __forceinline__ float shx(float v, int mask, int lane) { return __uint_as_float((unsigned)__builtin_amdgcn_ds_bpermute((lane ^ mask) << 2, (int)__float_as_uint(v))); }
__device__ __forceinline__ float wave_sum(float v, int lane) {
#pragma unroll
    for (int o = 1; o < 64; o <<= 1) v += shx(v, o, lane);
    return v;
}
__device__ __forceinline__ int crow(int r, int h) { return (r & 3) + 8 * (r >> 2) + 4 * h; }
__device__ __forceinline__ float bf2f(unsigned short b) { return __uint_as_float((unsigned)b << 16); }
__device__ __forceinline__ bf16x8 pack8(float a0, float a1, float a2, float a3, float a4, float a5, float a6, float a7) {
    u32x4 w; w.x = cvt_pk_bf16(a0, a1); w.y = cvt_pk_bf16(a2, a3); w.z = cvt_pk_bf16(a4, a5); w.w = cvt_pk_bf16(a6, a7);
    return __builtin_bit_cast(bf16x8, w);
}
__device__ __forceinline__ s16x4 vtr(const LAS unsigned char* p) {
    typedef short v4i16_t __attribute__((ext_vector_type(4)));
    return __builtin_bit_cast(s16x4, __builtin_amdgcn_ds_read_tr16_b64_v4i16((LAS v4i16_t*)p));
}
__device__ __forceinline__ bf16x8 cat4(s16x4 a, s16x4 b) { return (bf16x8){a[0], a[1], a[2], a[3], b[0], b[1], b[2], b[3]}; }
__device__ __forceinline__ float silu_f(float v) { return v * __builtin_amdgcn_rcpf(1.f + __builtin_amdgcn_exp2f(-v * LOG2E)); }

template <int MODE> struct EpiQKV {
    static constexpr bool PERM = true, AFTER_DRAIN = false;
    unsigned char* R; const float* tab;
    __device__ __forceinline__ void operator()(const f32x4 (&acc)[2][2][4][2], const pg8::Unit& u, int wr, int wc, int fr, int fq) const {
        const int row0 = u.pm * 256 + wr * 64 + fr;
        bf16_t* base; int ld, colt; int kind;
        if (MODE == 2) {
            if (u.pn < 4) { base = (bf16_t*)R; ld = 1024; colt = u.pn * 256; kind = 1; }
            else if (u.pn < 8) { base = (bf16_t*)(R + 36 * MiB); ld = 1024; colt = (u.pn - 4) * 256; kind = 2; }
            else if (u.pn < 16) { base = (bf16_t*)(R + 72 * MiB); ld = 2048; colt = (u.pn - 8) * 256; kind = 0; }
            else { base = (bf16_t*)(R + 144 * MiB); ld = 2048; colt = (u.pn - 16) * 256; kind = 3; }
        } else {
            const int sec = u.pn >> 2; base = (bf16_t*)(R + (size_t)sec * 36 * MiB); ld = 1024; colt = (u.pn & 3) * 256; kind = (MODE == 0 && sec < 2) ? 1 : 0;
        }
        const bool latent = u.pm < 64;
        if (!latent && (kind == 1 || kind == 2)) kind = (kind == 2) ? 4 : 0;
        const float ksc = 0.0625f;
#pragma unroll
        for (int ai = 0; ai < 2; ++ai)
#pragma unroll
            for (int m = 0; m < 4; ++m) {
                const int row = row0 + ai * 128 + m * 16;
                bf16_t* rowp = base + (size_t)row * ld + colt + wc * 32 + 8 * fq;
                const int t = row & 2047, grow = t >> 6, gcol = t & 63;
#pragma unroll
                for (int bj = 0; bj < 2; ++bj) {
                    f32x4 v0 = acc[ai][bj][m][0], v1 = acc[ai][bj][m][1];
                    if (kind == 1 || kind == 2) {
                        f32x4 cs, sn;
                        if (MODE == 0) { const int pos = (wc & 1) ? gcol : grow; const float* tp = tab + pos * 16 + 4 * fq; cs = *(const f32x4*)tp; sn = *(const f32x4*)(tp + 1024); }
                        else { const int pos = bj ? gcol : grow; const float* tp = tab + 2048 + pos * 64 + 16 * wc + 4 * fq; cs = *(const f32x4*)tp; sn = *(const f32x4*)(tp + 4096); }
                        const f32x4 o0 = v0 * cs - v1 * sn, o1 = v0 * sn + v1 * cs; v0 = o0; v1 = o1;
                    }
                    if (kind == 2 || kind == 4) { v0 = v0 * ksc; v1 = v1 * ksc; }
                    if (kind == 3) {
#pragma unroll
                        for (int e = 0; e < 4; ++e) { v0[e] = silu_f(v0[e]); v1[e] = silu_f(v1[e]); }
                    }
                    u32x4 w; w.x = cvt_pk_bf16(v0[0], v0[1]); w.y = cvt_pk_bf16(v0[2], v0[3]); w.z = cvt_pk_bf16(v1[0], v1[1]); w.w = cvt_pk_bf16(v1[2], v1[3]);
                    *(u32x4*)(rowp + bj * 128) = w;
                }
            }
    }
};
struct EpiSwiglu {
    static constexpr bool PERM = true, AFTER_DRAIN = false;
    bf16_t* O;
    __device__ __forceinline__ void operator()(const f32x4 (&acc)[2][2][4][2], const pg8::Unit& u, int wr, int wc, int fr, int fq) const {
        const int row0 = u.pm * 256 + wr * 64 + fr, col0 = (u.pn * 256 + wc * 32 + 8 * fq) >> 1;
#pragma unroll
        for (int ai = 0; ai < 2; ++ai)
#pragma unroll
            for (int m = 0; m < 4; ++m) {
                bf16_t* rowp = O + (size_t)(row0 + ai * 128 + m * 16) * FFH + col0;
#pragma unroll
                for (int bj = 0; bj < 2; ++bj) {
                    const f32x4 a = acc[ai][bj][m][0], b = acc[ai][bj][m][1];
                    u32x2 w; w.x = cvt_pk_bf16(silu_f(a[0]) * b[0], silu_f(a[1]) * b[1]); w.y = cvt_pk_bf16(silu_f(a[2]) * b[2], silu_f(a[3]) * b[3]);
                    *(u32x2*)(rowp + bj * 64) = w;
                }
            }
    }
};
template <int KT> struct EpiRes {
    static constexpr bool PERM = false, AFTER_DRAIN = false;
    float* XL; float* XC; const float* gate; float gs; float* PB;
    __device__ __forceinline__ void operator()(const f32x4 (&acc)[2][2][4][2], const pg8::Unit& u, int wr, int wc, int fr, int fq) const {
        const int row0 = u.pm * 256 + wr * 64 + fr, col0 = u.pn * 256 + wc * 32 + 4 * fq;
        const int mi = u.pm < 64 ? (u.pm >> 3) : 8;
        const bool split = u.nt != KT;
        float* xb = u.pm < 64 ? XL : (XC - (size_t)ML * DM);
        const ptrdiff_t pboff = split ? (PB + (size_t)u.part * MC * DM) - XC : 0;
        const float* gp = gate + mi * 6144 + col0;
        f32x4 gv[2][2];
#pragma unroll
        for (int bj = 0; bj < 2; ++bj)
#pragma unroll
            for (int n = 0; n < 2; ++n) gv[bj][n] = *(const f32x4*)(gp + bj * 128 + n * 16) * gs;
#pragma unroll
        for (int ai = 0; ai < 2; ++ai)
#pragma unroll
            for (int m = 0; m < 4; ++m) {
                float* rowp = xb + (size_t)(row0 + ai * 128 + m * 16) * DM + col0;
#pragma unroll
                for (int bj = 0; bj < 2; ++bj)
#pragma unroll
                    for (int n = 0; n < 2; ++n) {
                        const f32x4 v = gv[bj][n] * acc[ai][bj][m][n]; float* pe = rowp + bj * 128 + n * 16;
                        if (split) *(f32x4*)(pe + pboff) = v;
                        else { f32x4* p = (f32x4*)pe; *p = *p + v; }
                    }
            }
    }
};
template <int NN, int KT> struct Order8 {
    int nwg, G, c;
    __device__ __forceinline__ void init(int M, int G_, int c_) { nwg = (M / 256) * NN; G = G_; c = c_; }
    __device__ __forceinline__ bool next(int i, pg8::Unit& u) const {
        const int L = i * G + c; if (L >= nwg) return false;
        const int q = nwg >> 3, xcd = L & 7, off = L >> 3; const int wgid = xcd * q + off;
        constexpr int nig = 8 * NN; const int gid = wgid / nig, rem = wgid - gid * nig;
        u.pm = gid * 8 + (rem & 7); u.pn = rem >> 3; u.k0 = 0; u.nt = KT; u.part = 0; return true;
    }
    __device__ __forceinline__ void a_ready(const pg8::Unit&) const {}
    __device__ __forceinline__ void done(const pg8::Unit&) const {}
};
template <int K, int NS> struct OrderSplitK {
    int nlat, ntot, G, c;
    __device__ __forceinline__ void init(int M, int G_, int c_) { nlat = 256; ntot = 256 + (M > ML ? 32 * NS : 0); G = G_; c = c_; }
    __device__ __forceinline__ bool next(int i, pg8::Unit& u) const {
        const int L = i * G + c; if (L >= ntot) return false;
        if (L < nlat) { const int xcd = L & 7, off = L >> 3; const int wgid = xcd * 32 + off; const int gid = wgid >> 5, rem = wgid & 31; u.pm = gid * 8 + (rem & 7); u.pn = rem >> 3; u.k0 = 0; u.nt = K / 64; u.part = 0; return true; }
        const int s = L - nlat, t = s / NS, part = s - t * NS;
        constexpr int K128 = K / 128, base = K128 / NS, extra = K128 - base * NS;
        const int b0 = part * base + (part < extra ? part : extra), nb = base + (part < extra ? 1 : 0);
        u.pm = 64 + (t >> 2); u.pn = t & 3; u.k0 = b0 * 128; u.nt = nb * 2; u.part = part; return true;
    }
    __device__ __forceinline__ void a_ready(const pg8::Unit&) const {}
    __device__ __forceinline__ void done(const pg8::Unit&) const {}
};
template <int K, int NS, class Epi> __device__ __forceinline__ void run_gemm_res(LAS unsigned char* lds, const bf16_t* A, const bf16_t* Bt, int M, const Epi& E) {
    static_assert((K / 128) / NS >= 2, "every K part needs at least 256 of K");
    pg8::Gemm g{A, Bt, M, 1024, K}; OrderSplitK<K, NS> S; S.init(M, lgrid(), lbid());
    pg8::gemm_phase<Epi, OrderSplitK<K, NS>, true, true>(lds, g, S, E);
}
template <int N, int K, class Epi> __device__ __forceinline__ void run_gemm(LAS unsigned char* lds, const bf16_t* A, const bf16_t* Bt, int M, const Epi& E) {
    pg8::Gemm g{A, Bt, M, N, K}; Order8<N / 256, K / 64> S; S.init(M, lgrid(), lbid());
    pg8::gemm_phase<Epi, Order8<N / 256, K / 64>, true, true>(lds, g, S, E);
}

__device__ __forceinline__ int srccol(int g, int lim, int grp, int P) {
    if (g >= lim) return g;
    const int base = (g / grp) * grp, gl = g - base, u = gl >> 3, j = gl & 7;
    return base + 4 * u + (j & 3) + P * (j >> 2);
}
__device__ __forceinline__ void cvt_item(const float* __restrict__ W, int K, int N, bf16_t* WT, float* scr, int item, int lane, int lim, int grp, int P) {
    const int nblk = N / 32, kb = item / nblk, nb = item - kb * nblk, k0 = 64 * kb, n0 = 32 * nb;
    const int sc = srccol(n0 + (lane & 31), lim, grp, P);
#pragma unroll 8
    for (int i = 0; i < 32; ++i) { const int kk = 2 * i + (lane >> 5); scr[kk * 33 + (lane & 31)] = W[(size_t)(k0 + kk) * N + sc]; }
    __builtin_amdgcn_s_waitcnt(0); asm volatile("" ::: "memory");
    const int c = lane & 7;
#pragma unroll
    for (int j = 0; j < 4; ++j) {
        const int n = (lane >> 3) + 8 * j; const float* s = scr + (8 * c) * 33 + n;
        u32x4 o; o.x = cvt_pk_bf16(s[0], s[33]); o.y = cvt_pk_bf16(s[66], s[99]); o.z = cvt_pk_bf16(s[132], s[165]); o.w = cvt_pk_bf16(s[198], s[231]);
        *(u32x4*)(WT + (size_t)(n0 + n) * K + k0 + 8 * c) = o;
    }
    __builtin_amdgcn_s_waitcnt(0); asm volatile("" ::: "memory");
}
template <int NP> __device__ __forceinline__ void mod_row(float* xrow, const float* prow, const float* g, const float* sh, const float* sc, bf16_t* orow, int lane) {
    f32x4 v[4]; float s = 0.f;
#pragma unroll
    for (int j = 0; j < 4; ++j) { v[j] = *(const f32x4*)(xrow + 4 * lane + 256 * j);
        if (NP > 0) {
#pragma unroll
            for (int q = 0; q < NP; ++q) v[j] = v[j] + *(const f32x4*)(prow + (size_t)q * MC * DM + 4 * lane + 256 * j);
            *(f32x4*)(xrow + 4 * lane + 256 * j) = v[j]; }
        s += (v[j].x * v[j].x + v[j].y * v[j].y) + (v[j].z * v[j].z + v[j].w * v[j].w); }
    const float rstd = rsqrtf(wave_sum(s, lane) * (1.f / DM) + EPSV);
#pragma unroll
    for (int j = 0; j < 4; ++j) {
        const int c = 4 * lane + 256 * j;
        const f32x4 gg = *(const f32x4*)(g + c), ss = *(const f32x4*)(sc + c), hh = *(const f32x4*)(sh + c);
        const f32x4 o = v[j] * rstd * gg * (ss + 1.0f) + hh;
        u32x2 w; w.x = cvt_pk_bf16(o.x, o.y); w.y = cvt_pk_bf16(o.z, o.w);
        *(u32x2*)(orow + c) = w;
    }
}
#define XB_TMO      128
#define XB_XCNT(j)  (256  + 64 * (j))
#define XB_XSUB(j)  (1280 + 64 * (j))
#define XB_XGEN(j)  (2304 + 64 * (j))
#define XB_TOP      3328
#define XB_TOPGEN   3392
#define XCD_BAR_WORDS 3456
#define XB_SPIN_CAP (1u << 18)

__device__ __forceinline__ unsigned xb_ld(unsigned* p)              { return __hip_atomic_load(p, __ATOMIC_RELAXED, __HIP_MEMORY_SCOPE_AGENT); }
__device__ __forceinline__ unsigned xb_add(unsigned* p, unsigned v) { return __hip_atomic_fetch_add(p, v, __ATOMIC_RELAXED, __HIP_MEMORY_SCOPE_AGENT); }
__device__ __forceinline__ unsigned xb_xcc_id() { return (unsigned)__builtin_amdgcn_s_getreg((3 << 11) | 20) & 0xFu; }
#define XB_SPIN(cond, bar) do { unsigned _sp = 0; while (cond) { __builtin_amdgcn_s_sleep(1); \
    if ((++_sp & 255u) == 0u) { if (xb_ld(&(bar)[XB_TMO])) break; if (_sp > XB_SPIN_CAP) { atomicAdd(&(bar)[XB_TMO], 1u); break; } } } } while (0)

struct XcdBarrier {
    unsigned* bar; unsigned x;
    volatile LAS unsigned* st;
};

__device__ __forceinline__ XcdBarrier xcd_barrier_post(unsigned* bar, volatile LAS unsigned* st) {
    XcdBarrier b; b.bar = bar; b.x = xb_xcc_id(); b.st = st;
    if (threadIdx.x == 0) (void)xb_add(&bar[XB_XCNT(b.x)], 1u);
    return b;
}
__device__ __forceinline__ void xcd_barrier_complete(unsigned* bar, unsigned x, unsigned& nloc, unsigned& nx) {
    const unsigned G = gridDim.x * gridDim.y * gridDim.z;
    unsigned sum, cnt, mine, sp = 0u;
    for (;;) {
        sum = 0u; cnt = 0u; mine = 0u;
#pragma unroll
        for (unsigned j = 0; j < 16; ++j) { const unsigned c = xb_ld(&bar[XB_XCNT(j)]); sum += c; cnt += (c > 0u) ? 1u : 0u; mine = (j == x) ? c : mine; }
        if (sum == G) break;
        __builtin_amdgcn_s_sleep(1);
        if ((++sp & 255u) == 0u) { if (xb_ld(&bar[XB_TMO])) break; if (sp > XB_SPIN_CAP) { atomicAdd(&bar[XB_TMO], 1u); break; } }
    }
    nloc = mine > 0u ? mine : 1u; nx = cnt > 0u ? cnt : 1u;
}

__device__ __forceinline__ void xcd_barrier(const XcdBarrier& b) {
    asm volatile("s_waitcnt vmcnt(0)" ::: "memory");
    __syncthreads();
    if (threadIdx.x == 0) {
        unsigned* bar = b.bar;
        __builtin_amdgcn_s_waitcnt(0);
        unsigned nloc = b.st[0], nx = b.st[1];
        if (nloc == 0u) { xcd_barrier_complete(bar, b.x, nloc, nx); b.st[0] = nloc; b.st[1] = nx; }
        const unsigned old = xb_add(&bar[XB_XSUB(b.x)], 1u);
        const unsigned gen = old / nloc;
        if (old + 1u == (gen + 1u) * nloc) {
            __builtin_amdgcn_fence(__ATOMIC_RELEASE, "agent");
            asm volatile("s_waitcnt vmcnt(0)" ::: "memory");
            const unsigned og = xb_add(&bar[XB_TOP], 1u);
            const unsigned tg = og / nx;
            if (og + 1u == (tg + 1u) * nx) xb_add(&bar[XB_TOPGEN], 1u);
            else XB_SPIN(xb_ld(&bar[XB_TOPGEN]) == tg, bar);
            __builtin_amdgcn_fence(__ATOMIC_ACQUIRE, "agent");
            xb_add(&bar[XB_XGEN(b.x)], 1u);
            asm volatile("s_waitcnt vmcnt(0)" ::: "memory");
        } else {
            XB_SPIN(xb_ld(&bar[XB_XGEN(b.x)]) == gen, bar);
            __builtin_amdgcn_fence(__ATOMIC_ACQUIRE, "agent");
            asm volatile("s_waitcnt vmcnt(0)" ::: "memory");
        }
    }
    __syncthreads();
}
constexpr int FA_KT = 64 * 144;
template <int DV, bool SPLIT = false> struct FaCfg { static constexpr int KROW = SPLIT ? 272 : 144, KT = 64 * KROW, VROW = DV * 2 + 64, VT = 64 * VROW, KOFF = 0, VOFF = 2 * KT, SCR = VOFF + 2 * VT, RPB = SCR + 8 * 32 * 4; };

template <int DV, bool BIAS, bool SPLIT = false>
__device__ __forceinline__ void flash_unit(unsigned char* smem, const bf16_t* __restrict__ Qg, const bf16_t* __restrict__ Kg, const bf16_t* __restrict__ Vg,
                                           int nlat, int lat_row0, int nctx, int ctx_row0, int kr0, int qr, int c0, float* outF, bf16_t* outB, float lam = 0.f, float osc = 0.f, const float* subg = nullptr) {
    typedef FaCfg<DV, SPLIT> C;
    constexpr int NDB = DV / 32;
    const int tid = ltid(), lane = tid & 63, w = tid >> 6, h2 = lane >> 5, l31 = lane & 31;
    LAS unsigned char* lds = (LAS unsigned char*)smem;
    float* scr = (float*)(smem + C::SCR) + w * 32;
    const float* rpbL = (const float*)(smem + C::RPB);
    const int nt = nlat + nctx;
    const int krow = tid >> 3, kch = tid & 7;
    u32x4 kreg, kreg2, vreg0, vreg1;
    auto tile_row = [&](int t) { return t < nlat ? lat_row0 + 64 * t : ctx_row0 + 64 * (t - nlat); };
#define FA_LOADK(t) do { const int rg_ = tile_row(t); if (SPLIT) { kreg = *(const u32x4*)(Kg + (size_t)(rg_ + (tid >> 4)) * 1024 + (tid & 15) * 8); kreg2 = *(const u32x4*)(Kg + (size_t)(rg_ + 32 + (tid >> 4)) * 1024 + (tid & 15) * 8); } \
        else kreg = *(const u32x4*)(Kg + (size_t)(rg_ + krow) * 1024 + kch * 8); } while (0)
#define FA_LOADV(t) do { const int rg_ = tile_row(t); \
        if (DV == 128) { vreg0 = *(const u32x4*)(Vg + (size_t)(rg_ + (tid >> 4)) * 1024 + (tid & 15) * 8); vreg1 = *(const u32x4*)(Vg + (size_t)(rg_ + 32 + (tid >> 4)) * 1024 + (tid & 15) * 8); } \
        else { vreg0 = *(const u32x4*)(Vg + (size_t)(rg_ + krow) * 1024 + kch * 8); } } while (0)
#define FA_STOREK(buf) do { if (SPLIT) { *(LAS u32x4*)(lds + C::KOFF + (buf) * C::KT + (tid >> 4) * C::KROW + (tid & 15) * 16) = kreg; *(LAS u32x4*)(lds + C::KOFF + (buf) * C::KT + (32 + (tid >> 4)) * C::KROW + (tid & 15) * 16) = kreg2; } \
        else *(LAS u32x4*)(lds + C::KOFF + (buf) * C::KT + krow * C::KROW + kch * 16) = kreg; } while (0)
#define FA_STOREV(buf) do { \
        if (DV == 128) { *(LAS u32x4*)(lds + C::VOFF + (buf) * C::VT + (tid >> 4) * C::VROW + (tid & 15) * 16) = vreg0; *(LAS u32x4*)(lds + C::VOFF + (buf) * C::VT + (32 + (tid >> 4)) * C::VROW + (tid & 15) * 16) = vreg1; } \
        else { *(LAS u32x4*)(lds + C::VOFF + (buf) * C::VT + krow * C::VROW + kch * 16) = vreg0; } } while (0)
    bf16x8 qf[4];
#pragma unroll
    for (int ks = 0; ks < 4; ++ks) qf[ks] = *(const bf16x8*)(Qg + (size_t)l31 * 1024 + ks * 16 + h2 * 8);
    f32x16 O[NDB];
#pragma unroll
    for (int d = 0; d < NDB; ++d)
#pragma unroll
        for (int r = 0; r < 16; ++r) O[d][r] = 0.f;
    float mrun = -1e30f, lsum = 0.f;
    const int rs = qr - 4 < 0 ? 0 : (qr - 4 > 24 ? 24 : qr - 4);
    const int qc = c0 + l31, cs = qc - 8 < 0 ? 0 : (qc - 8 > 48 ? 48 : qc - 8);
    const int vlane = ((lane >> 4) & 1) * 32 + (lane & 3) * 8 + (4 * h2 + ((lane & 15) >> 2)) * C::VROW;
    FA_LOADK(0); FA_LOADV(0); FA_STOREK(0); FA_STOREV(0);
    if (nt > 1) { FA_LOADK(1); FA_STOREK(1); }
    __syncthreads();
    auto tile_act = [&](int t) { bool a = true; if (BIAS && t < nlat) { const int kr = kr0 + t; a = (kr >= rs) && (kr <= rs + 7); } return a; };
#define FA_QK(S0, S1, t_) do { const LAS unsigned char* kb = lds + C::KOFF + ((t_) & 1) * C::KT + l31 * C::KROW + h2 * 16 + (SPLIT ? (w >> 2) * 128 : 0); \
        _Pragma("unroll") for (int r = 0; r < 16; ++r) { S0[r] = 0.f; S1[r] = 0.f; } \
        _Pragma("unroll") for (int ks = 0; ks < 4; ++ks) { const bf16x8 a0_ = *(const LAS bf16x8*)(kb + ks * 32), a1_ = *(const LAS bf16x8*)(kb + 32 * C::KROW + ks * 32); \
            S0 = __builtin_amdgcn_mfma_f32_32x32x16_bf16(a0_, qf[ks], S0, 0, 0, 0); S1 = __builtin_amdgcn_mfma_f32_32x32x16_bf16(a1_, qf[ks], S1, 0, 0, 0); } } while (0)
    f32x16 sA0, sA1, sB0, sB1;
    if (tile_act(0)) FA_QK(sA0, sA1, 0);
    asm volatile("s_nop 15\n\ts_nop 7" : "+v"(sA0), "+v"(sA1));
    auto step = [&](f32x16& s0, f32x16& s1, f32x16& n0, f32x16& n1, const int t) __attribute__((always_inline)) {
        const int buf = t & 1;
        if (t + 2 < nt) FA_LOADK(t + 2);
        if (t + 1 < nt) FA_LOADV(t + 1);
        if (tile_act(t)) {
            float mx;
            const bool biased = BIAS && t < nlat;
            if (biased) {
                const int drow = (kr0 + t - qr + 7) * 32;
                int qcl = qc, csl = cs; asm volatile("" : "+v"(qcl), "+v"(csl));
#pragma unroll
                for (int r = 0; r < 16; ++r) {
                    const int k0 = crow(r, h2), k1 = k0 + 32;
                    int d0 = k0 - qcl + 15, d1 = k1 - qcl + 15; d0 = d0 < 0 ? 0 : (d0 > 30 ? 30 : d0); d1 = d1 < 0 ? 0 : (d1 > 30 ? 30 : d1);
                    const float b0 = rpbL[drow + d0], b1 = rpbL[drow + d1];
                    s0[r] = ((unsigned)(k0 - csl) < 16u) ? s0[r] * C2S + b0 * LOG2E : -1e30f;
                    s1[r] = ((unsigned)(k1 - csl) < 16u) ? s1[r] * C2S + b1 * LOG2E : -1e30f;
                }
            }
            {
                float ma, mb;
                asm volatile("s_nop 4" : "+v"(s0), "+v"(s1));
                asm("v_max3_f32 %0, %1, %2, %3" : "=v"(ma) : "v"(s0[0]), "v"(s0[1]), "v"(s1[0]));
                asm("v_max3_f32 %0, %1, %2, %3" : "=v"(mb) : "v"(s1[1]), "v"(s0[2]), "v"(s1[2]));
#pragma unroll
                for (int r = 3; r < 15; r += 2) {
                    asm("v_max3_f32 %0, %1, %2, %3" : "=v"(ma) : "v"(ma), "v"(s0[r]), "v"(s1[r]));
                    asm("v_max3_f32 %0, %1, %2, %3" : "=v"(mb) : "v"(mb), "v"(s0[r + 1]), "v"(s1[r + 1]));
                }
                asm("v_max3_f32 %0, %1, %2, %3" : "=v"(ma) : "v"(ma), "v"(s0[15]), "v"(s1[15]));
                asm("v_max_f32_e32 %0, %1, %2" : "=v"(mx) : "v"(ma), "v"(mb));
            }
            if (!biased) mx *= C2S;
            {
                asm volatile("s_nop 1" : "+v"(mx));
                const auto rr = __builtin_amdgcn_permlane32_swap(__float_as_uint(mx), __float_as_uint(mx), false, false);
                mx = fmaxf(__uint_as_float(rr[0]), __uint_as_float(rr[1]));
            }
            const bool grew = mx > mrun + 8.0f;
            const float mnew = grew ? mx : mrun, alpha = __builtin_amdgcn_exp2f(mrun - mnew);
            mrun = mnew;
            const float alpha_l = alpha;
            if (__builtin_amdgcn_ballot_w64(grew) != 0ull) {
                if (h2 == 0) scr[l31] = alpha;
                asm volatile("s_waitcnt lgkmcnt(0)" ::: "memory");
                float al[16];
#pragma unroll
                for (int r = 0; r < 16; ++r) al[r] = scr[crow(r, h2)];
#pragma unroll
                for (int d = 0; d < NDB; ++d)
#pragma unroll
                    for (int r = 0; r < 16; ++r) O[d][r] *= al[r];
            }
            bf16x8 pa[4];
            {
                const LAS unsigned char* kbn = lds + C::KOFF + ((t + 1) & 1) * C::KT + l31 * C::KROW + h2 * 16 + (SPLIT ? (w >> 2) * 128 : 0);
                bf16x8 ka0[4], ka1[4];
#pragma unroll
                for (int ks = 0; ks < 4; ++ks) { ka0[ks] = *(const LAS bf16x8*)(kbn + ks * 32); ka1[ks] = *(const LAS bf16x8*)(kbn + 32 * C::KROW + ks * 32); }
#pragma unroll
                for (int r = 0; r < 16; ++r) { n0[r] = 0.f; n1[r] = 0.f; }
                __builtin_amdgcn_sched_barrier(0);
#pragma unroll
                for (int ks = 0; ks < 4; ++ks) { n0 = __builtin_amdgcn_mfma_f32_32x32x16_bf16(ka0[ks], qf[ks], n0, 0, 0, 0); n1 = __builtin_amdgcn_mfma_f32_32x32x16_bf16(ka1[ks], qf[ks], n1, 0, 0, 0); }
            float ps = 0.f;
            if (biased) {
#pragma unroll
                for (int r = 0; r < 16; ++r) { s0[r] = __builtin_amdgcn_exp2f(s0[r] - mnew); s1[r] = __builtin_amdgcn_exp2f(s1[r] - mnew); ps += s0[r] + s1[r]; }
            } else {
#pragma unroll
                for (int r = 0; r < 16; ++r) { s0[r] = __builtin_amdgcn_exp2f(fmaf(s0[r], C2S, -mnew)); s1[r] = __builtin_amdgcn_exp2f(fmaf(s1[r], C2S, -mnew)); ps += s0[r] + s1[r]; }
            }
            lsum = lsum * alpha_l + ps;
            pa[0] = pack8(s0[0], s0[1], s0[2], s0[3], s0[4], s0[5], s0[6], s0[7]);
            pa[1] = pack8(s0[8], s0[9], s0[10], s0[11], s0[12], s0[13], s0[14], s0[15]);
            pa[2] = pack8(s1[0], s1[1], s1[2], s1[3], s1[4], s1[5], s1[6], s1[7]);
            pa[3] = pack8(s1[8], s1[9], s1[10], s1[11], s1[12], s1[13], s1[14], s1[15]);
#pragma unroll
                for (int g = 0; g < 8; ++g) { __builtin_amdgcn_sched_group_barrier(0x8, 1, 0); __builtin_amdgcn_sched_group_barrier(0x2, 16, 0); }
                __builtin_amdgcn_sched_barrier(0);
            }
            const LAS unsigned char* vb = lds + C::VOFF + buf * C::VT + vlane;
            bf16x8 vfr[2][4];
#pragma unroll
            for (int ks = 0; ks < 4; ++ks) vfr[0][ks] = cat4(vtr(vb + ks * 16 * C::VROW), vtr(vb + (ks * 16 + 8) * C::VROW));
#pragma unroll
            for (int d = 0; d < NDB; ++d) {
                if (d + 1 < NDB) {
#pragma unroll
                    for (int ks = 0; ks < 4; ++ks) vfr[(d + 1) & 1][ks] = cat4(vtr(vb + ks * 16 * C::VROW + (d + 1) * 64), vtr(vb + (ks * 16 + 8) * C::VROW + (d + 1) * 64));
                }
                __builtin_amdgcn_sched_barrier(0);
#pragma unroll
                for (int ks = 0; ks < 4; ++ks) O[d] = __builtin_amdgcn_mfma_f32_32x32x16_bf16(pa[ks], vfr[d & 1][ks], O[d], 0, 0, 0);
                __builtin_amdgcn_sched_barrier(0);
            }
        } else { FA_QK(n0, n1, t + 1); }
        if (t + 2 < nt) FA_STOREK(buf);
        if (t + 1 < nt) FA_STOREV(buf ^ 1);
        __syncthreads();
    };
    for (int t = 0; t < nt; t += 2) {
        step(sA0, sA1, sB0, sB1, t);
        if (t + 1 < nt) step(sB0, sB1, sA0, sA1, t + 1);
    }
#undef FA_LOADK
#undef FA_LOADV
#undef FA_STOREK
#undef FA_STOREV
#undef FA_QK
    lsum += shx(lsum, 32, lane);
    if (h2 == 0) scr[l31] = 1.f / lsum;
    __builtin_amdgcn_s_waitcnt(0xc07f); asm volatile("" ::: "memory");
    if (!SPLIT) {
#pragma unroll
        for (int r = 0; r < 16; ++r) {
            const float iv = scr[crow(r, h2)]; const int row = crow(r, h2);
#pragma unroll
            for (int d = 0; d < NDB; ++d) {
                if (DV == 128) outF[(size_t)row * 2048 + d * 32 + l31] = O[d][r] * iv;
                else { const float v = O[d][r] * iv; outB[(size_t)row * 1024 + d * 32 + l31] = (bf16_t)(cvt_pk_bf16(v, v) & 0xffffu); }
            }
        }
    } else {
        float* xch = (float*)smem + (w & 3) * (NDB * 16 * 64);
#pragma unroll
        for (int r = 0; r < 16; ++r) { const float iv = scr[crow(r, h2)];
#pragma unroll
            for (int d = 0; d < NDB; ++d) O[d][r] *= iv; }
        if (w >= 4) {
#pragma unroll
            for (int d = 0; d < NDB; ++d)
#pragma unroll
                for (int r = 0; r < 16; ++r) xch[(d * 16 + r) * 64 + lane] = O[d][r] * lam;
        }
        __syncthreads();
        if (w < 4) {
            float ss[16];
#pragma unroll
            for (int r = 0; r < 16; ++r) { ss[r] = 0.f;
#pragma unroll
                for (int d = 0; d < NDB; ++d) { O[d][r] -= xch[(d * 16 + r) * 64 + lane]; ss[r] += O[d][r] * O[d][r]; } }
#pragma unroll
            for (int r = 0; r < 16; ++r) {
#pragma unroll
                for (int o = 1; o < 32; o <<= 1) ss[r] += shx(ss[r], o, lane);
                ss[r] = rsqrtf(ss[r] * (1.f / 128.f) + EPSV) * osc;
            }
#pragma unroll
            for (int d = 0; d < NDB; ++d) { const float gg = subg[d * 32 + l31];
#pragma unroll
                for (int r = 0; r < 16; ++r) { const float v = O[d][r] * ss[r] * gg; outB[(size_t)crow(r, h2) * 1024 + d * 32 + l31] = (bf16_t)(cvt_pk_bf16(v, v) & 0xffffu); } }
        }
        __syncthreads();
    }
    __builtin_amdgcn_s_waitcnt(0xc07f); asm volatile("" ::: "memory");
}
__device__ __forceinline__ void ret_p_unit(const bf16_t* __restrict__ Q, const bf16_t* __restrict__ K, bf16_t* Pt, int b, int h, int ci, float lgf, float lgb) {
    const int tid = ltid(), lane = tid & 63, w = tid >> 6, h2 = lane >> 5, l31 = lane & 31;
    const int row0 = ci < 2 ? ML + b * CTXL + 128 * ci : b * SEQL + 128 * (ci - 2);
    const int ib = w & 3, jh = w >> 2;
    const bf16_t* qp = Q + (size_t)(row0 + 32 * ib + l31) * 1024 + h * 256 + h2 * 8;
    f32x16 s[2];
#pragma unroll
    for (int jb = 0; jb < 2; ++jb)
#pragma unroll
        for (int r = 0; r < 16; ++r) s[jb][r] = 0.f;
    const bf16_t* kp0 = K + (size_t)(row0 + 64 * jh + l31) * 1024 + h * 256 + h2 * 8;
#pragma unroll 4
    for (int ks = 0; ks < 16; ++ks) {
        const bf16x8 a = *(const bf16x8*)(qp + ks * 16);
        const bf16x8 b0 = *(const bf16x8*)(kp0 + ks * 16), b1 = *(const bf16x8*)(kp0 + 32 * 1024 + ks * 16);
        s[0] = __builtin_amdgcn_mfma_f32_32x32x16_bf16(a, b0, s[0], 0, 0, 0);
        s[1] = __builtin_amdgcn_mfma_f32_32x32x16_bf16(a, b1, s[1], 0, 0, 0);
    }
    bf16_t* pf = Pt + ((size_t)((0 * 8 + b) * 4 + h) * 18 + ci) * 16384;
    bf16_t* pb = Pt + ((size_t)((1 * 8 + b) * 4 + h) * 18 + ci) * 16384;
#pragma unroll
    for (int jb = 0; jb < 2; ++jb)
#pragma unroll
        for (int r = 0; r < 16; ++r) {
            const int i = 32 * ib + crow(r, h2), j = 64 * jh + 32 * jb + l31, df = i - j;
            const float v = s[jb][r];
            const float vf = df >= 0 ? v * __builtin_amdgcn_exp2f((float)df * lgf) : 0.f;
            const float vb = df < 0 ? v * __builtin_amdgcn_exp2f((float)(-df) * lgb) : 0.f;
            pf[i * 128 + j] = (bf16_t)(cvt_pk_bf16(vf, vf) & 0xffffu);
            pb[i * 128 + j] = (bf16_t)(cvt_pk_bf16(vb, vb) & 0xffffu);
        }
}
constexpr int RS_VROW = 192, RS_KROW = 576, RS_SROW = 528, RS_VOFF = 0, RS_VZOFF = 128 * RS_VROW, RS_KOFF = 2 * 128 * RS_VROW, RS_SOFF = RS_KOFF + 128 * RS_KROW;
static_assert(RS_SOFF + 64 * RS_SROW <= LDS_BYTES - 64, "retention scan LDS");
__device__ __forceinline__ void ret_scan_unit(unsigned char* smem, const bf16_t* __restrict__ Q, const bf16_t* __restrict__ K, const bf16_t* __restrict__ V,
                                              const bf16_t* __restrict__ Pt, bf16_t* OX, int b, int h, int dvs, const float* lg) {
    const int tid0 = ltid();
    LAS unsigned char* lds = (LAS unsigned char*)smem;
    for (int dir = 1; dir >= 0; --dir) {
        const float lgd = __uint_as_float(__builtin_amdgcn_readfirstlane(__float_as_uint(lg[dir * 4 + h])));
        const float gC = __uint_as_float(__builtin_amdgcn_readfirstlane(__float_as_uint(__builtin_amdgcn_exp2f(128.f * lgd))));
        f32x16 S[2];
#pragma unroll
        for (int d = 0; d < 2; ++d)
#pragma unroll
            for (int r = 0; r < 16; ++r) S[d][r] = 0.f;
        u32x4 kv[8], vv[2];
        for (int step = 0; step < 18; ++step) {
            int ci;
            if (step < 2) ci = dir ? 1 - step : step; else ci = dir ? 2 + (15 - (step - 2)) : step;
            const int row0 = ci < 2 ? ML + b * CTXL + 128 * ci : b * SEQL + 128 * (ci - 2);
            int tid = tid0; asm volatile("" : "+v"(tid));
            const int lane = tid & 63, w = __builtin_amdgcn_readfirstlane(tid >> 6), h2 = lane >> 5, l31 = lane & 31, dvb = w & 1, ib = w >> 1;
            const int trl = ((lane >> 4) & 1) * 32 + (lane & 3) * 8;
            const int trr = ((lane & 15) >> 2);
            bf16x8 qf[16], pfr[8];
            {
                const bf16_t* qp = Q + (size_t)(row0 + 32 * ib + l31) * 1024 + h * 256 + 8 * h2;
#pragma unroll
                for (int f = 0; f < 16; ++f) qf[f] = *(const bf16x8*)(qp + 16 * f);
                const bf16_t* pp = Pt + ((size_t)((dir * 8 + b) * 4 + h) * 18 + ci) * 16384 + (size_t)(32 * ib + l31) * 128 + 8 * h2;
#pragma unroll
                for (int ks = 0; ks < 8; ++ks) pfr[ks] = *(const bf16x8*)(pp + ks * 16);
            }
            bf16_t* op = OX + (size_t)(row0 + 32 * ib) * 2048 + h * 512 + dvs * 64 + dvb * 32 + l31;
            unsigned short prev[16];
            if (dir == 0) {
#pragma unroll
                for (int r = 0; r < 16; ++r) prev[r] = op[(size_t)crow(r, h2) * 2048];
            }
            if (step == 0) {
#pragma unroll
                for (int i = 0; i < 8; ++i) { const int id = tid + 512 * i, r = id >> 5, ch = id & 31; kv[i] = *(const u32x4*)(K + (size_t)(row0 + r) * 1024 + h * 256 + ch * 8); }
#pragma unroll
                for (int i = 0; i < 2; ++i) { const int id = tid + 512 * i, r = id >> 3, ch = id & 7; vv[i] = *(const u32x4*)(V + (size_t)(row0 + r) * 2048 + h * 512 + dvs * 64 + ch * 8); }
            }
            asm volatile("s_waitcnt lgkmcnt(0)\n\ts_barrier" ::: "memory");
#pragma unroll
            for (int d = 0; d < 2; ++d)
#pragma unroll
                for (int g = 0; g < 4; ++g) {
                    u32x2 o; o.x = cvt_pk_bf16(S[d][4 * g], S[d][4 * g + 1]); o.y = cvt_pk_bf16(S[d][4 * g + 2], S[d][4 * g + 3]);
                    *(LAS u32x2*)(lds + RS_SOFF + (32 * dvb + l31) * RS_SROW + (32 * (2 * ib + d) + 8 * g + 4 * h2) * 2) = o;
                }
#pragma unroll
            for (int i = 0; i < 8; ++i) { const int id = tid + 512 * i, r = id >> 5, ch = id & 31; *(LAS u32x4*)(lds + RS_KOFF + r * RS_KROW + ch * 16) = kv[i]; }
#pragma unroll
            for (int i = 0; i < 2; ++i) {
                const int id = tid + 512 * i, r = id >> 3, ch = id & 7;
                const int jp = dir ? 127 - r : r;
                const float z = __builtin_amdgcn_exp2f((float)(127 - jp) * lgd);
                u32x4 o;
#pragma unroll
                for (int e = 0; e < 4; ++e) { const unsigned x = vv[i][e]; o[e] = cvt_pk_bf16(__uint_as_float(x << 16) * z, __uint_as_float(x & 0xffff0000u) * z); }
                *(LAS u32x4*)(lds + RS_VOFF + r * RS_VROW + ch * 16) = vv[i];
                *(LAS u32x4*)(lds + RS_VZOFF + r * RS_VROW + ch * 16) = o;
            }
            asm volatile("s_waitcnt lgkmcnt(0)\n\ts_barrier" ::: "memory");
            if (step + 1 < 18) {
                const int sn = step + 1; int cn;
                if (sn < 2) cn = dir ? 1 - sn : sn; else cn = dir ? 2 + (15 - (sn - 2)) : sn;
                const int rown = cn < 2 ? ML + b * CTXL + 128 * cn : b * SEQL + 128 * (cn - 2);
#pragma unroll
                for (int i = 0; i < 8; ++i) { const int id = tid + 512 * i, r = id >> 5, ch = id & 31; kv[i] = *(const u32x4*)(K + (size_t)(rown + r) * 1024 + h * 256 + ch * 8); }
#pragma unroll
                for (int i = 0; i < 2; ++i) { const int id = tid + 512 * i, r = id >> 3, ch = id & 7; vv[i] = *(const u32x4*)(V + (size_t)(rown + r) * 2048 + h * 512 + dvs * 64 + ch * 8); }
            }
            f32x16 acc;
#pragma unroll
            for (int r = 0; r < 16; ++r) acc[r] = 0.f;
            {
                const LAS unsigned char* sb = lds + RS_SOFF + (32 * dvb + l31) * RS_SROW + 16 * h2;
#pragma unroll
                for (int g = 0; g < 2; ++g) {
                    bf16x8 sfr[8];
#pragma unroll
                    for (int f = 0; f < 8; ++f) sfr[f] = *(const LAS bf16x8*)(sb + 32 * (8 * g + f));
                    __builtin_amdgcn_sched_barrier(0);
#pragma unroll
                    for (int f = 0; f < 8; ++f) acc = __builtin_amdgcn_mfma_f32_32x32x16_bf16(qf[8 * g + f], sfr[f], acc, 0, 0, 0);
                    __builtin_amdgcn_sched_barrier(0);
                }
            }
#pragma unroll
            for (int r = 0; r < 16; ++r) {
                const int i = 32 * ib + crow(r, h2), ip = dir ? 127 - i : i;
                acc[r] *= __builtin_amdgcn_exp2f((float)(ip + 1) * lgd);
            }
            {
                const LAS unsigned char* vbase = lds + RS_VOFF + (8 * h2 + trr) * RS_VROW + dvb * 64 + trl;
                bf16x8 vfa[8];
#pragma unroll
                for (int ks = 0; ks < 8; ++ks) vfa[ks] = cat4(vtr(vbase + ks * 16 * RS_VROW), vtr(vbase + (ks * 16 + 4) * RS_VROW));
                __builtin_amdgcn_sched_barrier(0);
#pragma unroll
                for (int ks = 0; ks < 8; ++ks) acc = __builtin_amdgcn_mfma_f32_32x32x16_bf16(pfr[ks], vfa[ks], acc, 0, 0, 0);
                __builtin_amdgcn_sched_barrier(0);
            }
#pragma unroll
            for (int r = 0; r < 16; ++r) {
                float v = acc[r];
                if (dir == 0) v += bf2f(prev[r]);
                op[(size_t)crow(r, h2) * 2048] = (bf16_t)(cvt_pk_bf16(v, v) & 0xffffu);
            }
            {
                const LAS unsigned char* kb = lds + RS_KOFF + (8 * h2 + trr) * RS_KROW + trl + (2 * ib) * 64;
                const LAS unsigned char* vzb = lds + RS_VZOFF + (8 * h2 + trr) * RS_VROW + dvb * 64 + trl;
#pragma unroll
                for (int d = 0; d < 2; ++d)
#pragma unroll
                    for (int r = 0; r < 16; ++r) S[d][r] *= gC;
                bf16x8 uf[2][3];
#define RS_UPD_LOAD(st, ks_) do { uf[st][0] = cat4(vtr(vzb + (ks_) * 16 * RS_VROW), vtr(vzb + ((ks_) * 16 + 4) * RS_VROW)); \
        uf[st][1] = cat4(vtr(kb + (ks_) * 16 * RS_KROW), vtr(kb + ((ks_) * 16 + 4) * RS_KROW)); uf[st][2] = cat4(vtr(kb + (ks_) * 16 * RS_KROW + 64), vtr(kb + ((ks_) * 16 + 4) * RS_KROW + 64)); } while (0)
                RS_UPD_LOAD(0, 0);
#pragma unroll
                for (int ks = 0; ks < 8; ++ks) {
                    if (ks + 1 < 8) RS_UPD_LOAD((ks + 1) & 1, ks + 1);
                    __builtin_amdgcn_sched_barrier(0);
                    S[0] = __builtin_amdgcn_mfma_f32_32x32x16_bf16(uf[ks & 1][1], uf[ks & 1][0], S[0], 0, 0, 0);
                    S[1] = __builtin_amdgcn_mfma_f32_32x32x16_bf16(uf[ks & 1][2], uf[ks & 1][0], S[1], 0, 0, 0);
                    __builtin_amdgcn_sched_barrier(0);
                }
#undef RS_UPD_LOAD
            }
        }
        __builtin_amdgcn_s_waitcnt(0); __syncthreads();
    }
}
#ifndef REP_P0
#define REP_P0 1
#endif
#ifndef REP_C
#define REP_C 1
#endif
#ifndef REP_G24
#define REP_G24 1
#endif
#ifndef REP_GS
#define REP_GS 1
#endif
#ifndef REP_RC
#define REP_RC 1
#endif
#ifndef REP_FIN
#define REP_FIN 1
#endif
#ifndef REP_G
#define REP_G 1
#endif
#ifndef REP_DA
#define REP_DA 1
#endif
#ifndef REP_RS
#define REP_RS 1
#endif
#ifndef REP_SYNC
#define REP_SYNC 1
#endif
#ifndef REP_NA
#define REP_NA 1
#endif
#ifndef REP_N
#define REP_N 1
#endif
#ifndef REP_RP
#define REP_RP 1
#endif
#ifndef EN_G1A
#define EN_G1A 1
#endif
#ifndef EN_G1B
#define EN_G1B 1
#endif
#ifndef EN_G1C
#define EN_G1C 1
#endif
#ifndef EN_DA
#define EN_DA 1
#endif
#ifndef EN_RP
#define EN_RP 1
#endif
#ifndef EN_RS
#define EN_RS 1
#endif
#ifndef EN_NA
#define EN_NA 1
#endif
#ifndef EN_G2
#define EN_G2 1
#endif
#ifndef EN_G3
#define EN_G3 1
#endif
#ifndef EN_G4
#define EN_G4 1
#endif

typedef const __attribute__((address_space(4))) Params* KParams;
__device__ __forceinline__ KParams get_params() { KParams kp = (KParams)__builtin_amdgcn_kernarg_segment_ptr(); asm volatile("" : "+s"(kp)); return kp; }
#define PH_PTRS \
    KParams kp_ = get_params(); const auto& p = *kp_; \
    unsigned char* ws = p.ws; float* XL = p.out; float* XC = (float*)(ws + WS_XC); float* mods = (float*)(ws + WS_MODS); float* tab = (float*)(ws + WS_TAB); float* lgt = tab + 10240; \
    bf16_t* H = (bf16_t*)(ws + WS_H); unsigned char* R = ws + WS_R; \
    (void)XL; (void)XC; (void)mods; (void)tab; (void)lgt; (void)H; (void)R;
#define PH_IDS const int tid = ltid(), lane = tid & 63, wave = __builtin_amdgcn_readfirstlane(tid >> 6); const int G = lgrid(), bid = lbid(), gw = bid * 8 + wave, NGW = G * 8; (void)lane; (void)gw; (void)NGW; (void)bid; (void)G;

__device__ __forceinline__ void ph_prologue(unsigned char* smem) {
    PH_PTRS PH_IDS
    const size_t gt = (size_t)bid * 512 + tid, NT = (size_t)G * 512;
    for (size_t i = gt; i < (size_t)ML * DM / 4; i += NT) ((f32x4*)XL)[i] = ((const f32x4*)p.x)[i];
    for (size_t i = gt; i < (size_t)MC * DM / 4; i += NT) ((f32x4*)XC)[i] = ((const f32x4*)p.ctx)[i];
    for (size_t i = gt; i < 1024 + 4096 + 8; i += NT) {
        if (i < 1024) { const int pos = (int)i >> 4, f = (int)i & 15; const float inv = __builtin_amdgcn_exp2f(-(float)f * (13.287712379549449f / 16.f));
            float a = (float)pos * inv; const float n = rintf(a * 0.15915494309189535f); a = fmaf(-n, 6.2831854820251465f, a); a = fmaf(-n, -1.7484556e-7f, a);
            tab[i] = __cosf(a); tab[1024 + i] = __sinf(a); }
        else if (i < 5120) { const int k = (int)i - 1024, pos = k >> 6, f = k & 63; const float inv = __builtin_amdgcn_exp2f(-(float)f * (13.287712379549449f / 64.f));
            float a = (float)pos * inv; const float n = rintf(a * 0.15915494309189535f); a = fmaf(-n, 6.2831854820251465f, a); a = fmaf(-n, -1.7484556e-7f, a);
            tab[2048 + k] = __cosf(a); tab[2048 + 4096 + k] = __sinf(a); }
        else { const int k = (int)i - 5120; lgt[k] = -log1pf(__expf(-p.ret_decay[k])) * LOG2E; }
    }
    float* cl = (float*)smem;
    float* red = cl + 9 * 1024;
    for (int i = tid; i < 9 * 1024; i += 512) { const float v = i < 8192 ? p.c[i] : p.c_ctx[i - 8192]; cl[i] = silu_f(v); }
    __syncthreads();
    for (int tile = bid; tile < 4 * 96; tile += G) {
        const int li = tile / 96, cb = tile - li * 96, col = cb * 64 + (tid & 63), kq = tid >> 6;
        const float* wp = p.w_ada + (size_t)li * 1024 * 6144 + (size_t)(kq * 128) * 6144 + col;
        float a[9];
#pragma unroll
        for (int m = 0; m < 9; ++m) a[m] = 0.f;
#pragma unroll 4
        for (int k = 0; k < 128; ++k) { const float wv = wp[(size_t)k * 6144];
#pragma unroll
            for (int m = 0; m < 9; ++m) a[m] += cl[m * 1024 + kq * 128 + k] * wv; }
#pragma unroll
        for (int m = 0; m < 9; ++m) red[(kq * 9 + m) * 64 + (tid & 63)] = a[m];
        __syncthreads();
        for (int o = tid; o < 9 * 64; o += 512) { const int m = o >> 6, cc = o & 63; float s = 0.f;
#pragma unroll
            for (int q = 0; q < 8; ++q) s += red[(q * 9 + m) * 64 + cc];
            mods[(size_t)(li * 9 + m) * 6144 + cb * 64 + cc] = s + p.b_ada[li * 6144 + cb * 64 + cc]; }
        __syncthreads();
    }
}
__device__ __forceinline__ void ph_cvt_norm1(unsigned char* smem, int li) {
    PH_PTRS PH_IDS
    const int kind = li % 3; const float* md = mods + (size_t)li * 9 * 6144;
    bf16_t *Wqkv = (bf16_t*)(ws + WS_WQKV), *Wo = (bf16_t*)(ws + WS_WO), *Wf1 = (bf16_t*)(ws + WS_WF1), *Wf2 = (bf16_t*)(ws + WS_WF2);
    float* scr = (float*)smem + wave * (64 * 33);
    const float *wq, *wo; int nq, ko, lim, grp, P;
    if (kind == 0) { const int ia = li / 3; wq = p.da_w_qkv + (size_t)ia * 1024 * 3072; wo = p.da_w_o + (size_t)ia * 1024 * 1024; nq = 3072; ko = 1024; lim = 2048; grp = 64; P = 32; }
    else if (kind == 1) { wq = p.ret_w_in; wo = p.ret_w_o; nq = 6144; ko = 2048; lim = 2048; grp = 256; P = 128; }
    else { wq = p.na_w_qkv; wo = p.na_w_o; nq = 3072; ko = 1024; lim = 0; grp = 64; P = 32; }
    const int I1 = 16 * (nq / 32), I2 = (ko / 64) * 32, I3 = 16 * (5632 / 32), I4 = 44 * 32;
    for (int it = gw; it < I1 + I2 + I3 + I4; it += NGW) {
        int r = it;
        if (r < I1) { cvt_item(wq, 1024, nq, Wqkv, scr, r, lane, lim, grp, P); continue; } r -= I1;
        if (r < I2) { cvt_item(wo, ko, 1024, Wo, scr, r, lane, 0, 64, 32); continue; } r -= I2;
        if (r < I3) { cvt_item(p.ffn_in + (size_t)li * 1024 * 5632, 1024, 5632, Wf1, scr, r, lane, 5632, 5632, 2816); continue; } r -= I3;
        cvt_item(p.ffn_out + (size_t)li * 2816 * 1024, 2816, 1024, Wf2, scr, r, lane, 0, 64, 32);
    }
    const float* g1 = p.norm_g + (size_t)(li * 2) * 1024;
    for (int row = gw; row < MT; row += NGW) {
        const int mi = row < ML ? row >> 11 : 8;
        if (row < ML || li == 0) { float* xr = row < ML ? XL + (size_t)row * DM : XC + (size_t)(row - ML) * DM; mod_row<0>(xr, nullptr, g1, md + mi * 6144, md + mi * 6144 + 1024, H + (size_t)row * DM, lane); }
        else mod_row<4>(XC + (size_t)(row - ML) * DM, (const float*)(R + 108 * MiB) + (size_t)(row - ML) * DM, g1, md + mi * 6144, md + mi * 6144 + 1024, H + (size_t)row * DM, lane);
    }
}
__device__ __forceinline__ void ph_norm2(int li) {
    PH_PTRS PH_IDS
    const float* md = mods + (size_t)li * 9 * 6144; const int MR = li < 3 ? MT : ML;
    const float* g2 = p.norm_g + (size_t)(li * 2 + 1) * 1024;
    for (int row = gw; row < MR; row += NGW) {
        const int mi = row < ML ? row >> 11 : 8;
        if (row < ML) mod_row<0>(XL + (size_t)row * DM, nullptr, g2, md + mi * 6144 + 3 * 1024, md + mi * 6144 + 4 * 1024, H + (size_t)row * DM, lane);
        else mod_row<4>(XC + (size_t)(row - ML) * DM, (const float*)(R + 36 * MiB) + (size_t)(row - ML) * DM, g2, md + mi * 6144 + 3 * 1024, md + mi * 6144 + 4 * 1024, H + (size_t)row * DM, lane);
    }
}
__device__ __forceinline__ void ph_da_attn(unsigned char* smem, int li) {
    PH_PTRS PH_IDS
    const bf16_t *Q = (const bf16_t*)R, *K = (const bf16_t*)(R + 36 * MiB), *V = (const bf16_t*)(R + 72 * MiB); bf16_t* O = (bf16_t*)(R + 108 * MiB);
    const int ia = li / 3; const float lam_init = li == 0 ? 0.2f : 0.55605802f;
    const float* lp = p.da_lambda + ia * 256;
    const float lam = expf(wave_sum(lp[lane] * lp[64 + lane], lane)) - expf(wave_sum(lp[128 + lane] * lp[192 + lane], lane)) + lam_init;
    const float* sg = p.da_subln + ia * 128;
    const int nun = 1024 + (li < 3 ? 128 : 0);
    const int mapw = wave >> 2, qw = wave & 3;
    for (int u = bid; u < nun; u += G) {
        int b, h, q0, nlat;
        if (u < 1024) { const int x = u & 7, s = (u & 255) >> 3 | (u >> 8) << 5, combo = x + 8 * (s >> 4); b = combo >> 3; h = combo & 7; q0 = b * SEQL + (s & 15) * 128; nlat = 32; }
        else { const int v = u - 1024; b = v >> 4; h = (v >> 1) & 7; q0 = ML + b * CTXL + (v & 1) * 128; nlat = 0; }
        q0 += qw * 32;
        flash_unit<128, false, true>(smem, Q + (size_t)q0 * 1024 + (2 * h + mapw) * 64, K + h * 128, V + h * 128, nlat, b * SEQL, 4, ML + b * CTXL, 0, 0, 0, nullptr,
                                     O + (size_t)q0 * 1024 + h * 128, lam, 1.f - lam_init, sg);
    }
}
__device__ __forceinline__ void ph_da_combine(int li) {
    PH_PTRS PH_IDS
    float* OM = (float*)(R + 108 * MiB); bf16_t* O = (bf16_t*)R; const int MR = li < 3 ? MT : ML;
    const int ia = li / 3; const float lam_init = li == 0 ? 0.2f : 0.55605802f;
    const float* lp = p.da_lambda + ia * 256;
    const float lam = expf(wave_sum(lp[lane] * lp[64 + lane], lane)) - expf(wave_sum(lp[128 + lane] * lp[192 + lane], lane)) + lam_init;
    const int hh = lane >> 3, d0 = (lane & 7) * 16;
    const float* sg = p.da_subln + ia * 128 + d0;
    for (int row = gw; row < MR; row += NGW) {
        const float* a = OM + (size_t)row * 2048 + hh * 256 + d0;
        f32x4 o[4]; float ss = 0.f;
#pragma unroll
        for (int j = 0; j < 4; ++j) { o[j] = *(const f32x4*)(a + 4 * j) - *(const f32x4*)(a + 128 + 4 * j) * lam; ss += (o[j].x * o[j].x + o[j].y * o[j].y) + (o[j].z * o[j].z + o[j].w * o[j].w); }
        ss += shx(ss, 1, lane); ss += shx(ss, 2, lane); ss += shx(ss, 4, lane);
        const float rstd = rsqrtf(ss * (1.f / 128.f) + EPSV) * (1.f - lam_init);
        u32x4 w0, w1;
        { const f32x4 g0 = *(const f32x4*)sg, g1 = *(const f32x4*)(sg + 4), g2 = *(const f32x4*)(sg + 8), g3 = *(const f32x4*)(sg + 12);
          const f32x4 a0 = o[0] * rstd * g0, a1 = o[1] * rstd * g1, a2 = o[2] * rstd * g2, a3 = o[3] * rstd * g3;
          w0.x = cvt_pk_bf16(a0.x, a0.y); w0.y = cvt_pk_bf16(a0.z, a0.w); w0.z = cvt_pk_bf16(a1.x, a1.y); w0.w = cvt_pk_bf16(a1.z, a1.w);
          w1.x = cvt_pk_bf16(a2.x, a2.y); w1.y = cvt_pk_bf16(a2.z, a2.w); w1.z = cvt_pk_bf16(a3.x, a3.y); w1.w = cvt_pk_bf16(a3.z, a3.w); }
        bf16_t* op = O + (size_t)row * 1024 + hh * 128 + d0;
        *(u32x4*)op = w0; *(u32x4*)(op + 8) = w1;
    }
}
__device__ __forceinline__ void ph_ret_p() {
    PH_PTRS PH_IDS
    const bf16_t *Q = (const bf16_t*)R, *K = (const bf16_t*)(R + 36 * MiB); bf16_t* Pt = H;
    for (int u = bid; u < 576; u += G) { const int b = u / 72, r = u - b * 72, h = r / 18, ci = r - h * 18; ret_p_unit(Q, K, Pt, b, h, ci, lgt[h], lgt[4 + h]); }
}
__device__ __forceinline__ void ph_ret_scan(unsigned char* smem) {
    PH_PTRS PH_IDS
    const bf16_t *Q = (const bf16_t*)R, *K = (const bf16_t*)(R + 36 * MiB), *V = (const bf16_t*)(R + 72 * MiB); bf16_t* OX = (bf16_t*)(R + 216 * MiB); bf16_t* Pt = H;
    for (int u = bid; u < 256; u += G) { const int x = u & 7, j = u >> 3, combo = x * 4 + (j >> 3), b = combo >> 2, h = combo & 3, dvs = j & 7;
        ret_scan_unit(smem, Q, K, V, Pt, OX, b, h, dvs, lgt); }
}
__device__ __forceinline__ void ph_ret_combine() {
    PH_PTRS PH_IDS
    bf16_t* Gt = (bf16_t*)(R + 144 * MiB); bf16_t* OX = (bf16_t*)(R + 216 * MiB);
    for (int row = gw; row < MT; row += NGW) {
        const bf16_t* ox = OX + (size_t)row * 2048 + lane * 32; bf16_t* gp = Gt + (size_t)row * 2048 + lane * 32;
        u32x4 v[4]; float ss = 0.f;
#pragma unroll
        for (int j = 0; j < 4; ++j) { v[j] = *(const u32x4*)(ox + 8 * j);
#pragma unroll
            for (int e = 0; e < 4; ++e) { const float a = __uint_as_float(v[j][e] << 16), b2 = __uint_as_float(v[j][e] & 0xffff0000u); ss += a * a + b2 * b2; } }
        ss += shx(ss, 1, lane); ss += shx(ss, 2, lane); ss += shx(ss, 4, lane); ss += shx(ss, 8, lane);
        const float rstd = rsqrtf(ss * (1.f / 512.f) + EPSV);
#pragma unroll
        for (int j = 0; j < 4; ++j) { const u32x4 g = *(const u32x4*)(gp + 8 * j); u32x4 o;
#pragma unroll
            for (int e = 0; e < 4; ++e) { const float a = __uint_as_float(v[j][e] << 16) * rstd * __uint_as_float(g[e] << 16), b2 = __uint_as_float(v[j][e] & 0xffff0000u) * rstd * __uint_as_float(g[e] & 0xffff0000u); o[e] = cvt_pk_bf16(a, b2); }
            *(u32x4*)(gp + 8 * j) = o; }
    }
}
__device__ __forceinline__ void ph_na(unsigned char* smem) {
    PH_PTRS PH_IDS
    const bf16_t *Q = (const bf16_t*)R, *K = (const bf16_t*)(R + 36 * MiB), *V = (const bf16_t*)(R + 72 * MiB); bf16_t* O = (bf16_t*)(R + 108 * MiB);
    float* rpbL = (float*)(smem + FaCfg<64>::RPB);
    for (int u = bid; u < 1024 + 128; u += G) {
        if (u < 1024) { const int x = u & 7, s = (u & 255) >> 3 | (u >> 8) << 5, combo = x + 8 * (s >> 3), b = combo >> 4, h = combo & 15, r4 = s & 7;
            for (int i = tid; i < 465; i += 512) rpbL[(i / 31) * 32 + (i % 31)] = p.na_rpb[h * 465 + i];
            int lo = 4 * r4 - 4; lo = lo < 0 ? 0 : (lo > 24 ? 24 : lo); int hi = 4 * r4 + 3 - 4; hi = (hi < 0 ? 0 : (hi > 24 ? 24 : hi)) + 7;
            const int qr = 4 * r4 + (wave >> 1), c0 = 32 * (wave & 1); const int q0 = b * SEQL + qr * 64 + c0;
            flash_unit<64, true>(smem, Q + (size_t)q0 * 1024 + h * 64, K + h * 64, V + h * 64, hi - lo + 1, b * SEQL + 64 * lo, 4, ML + b * CTXL, lo, qr, c0, nullptr, O + (size_t)q0 * 1024 + h * 64); }
        else { const int v = u - 1024, b = v >> 4, h = v & 15; const int q0 = ML + b * CTXL + wave * 32;
            flash_unit<64, false>(smem, Q + (size_t)q0 * 1024 + h * 64, K + h * 64, V + h * 64, 0, 0, 4, ML + b * CTXL, 0, 0, 0, nullptr, O + (size_t)q0 * 1024 + h * 64); }
    }
}
__device__ __forceinline__ void ph_final() {
    PH_PTRS PH_IDS
    for (int row = gw; row < ML; row += NGW) {
        float* xr = XL + (size_t)row * DM; f32x4 v[4]; float s = 0.f;
#pragma unroll
        for (int j = 0; j < 4; ++j) { v[j] = *(const f32x4*)(xr + 4 * lane + 256 * j); s += (v[j].x * v[j].x + v[j].y * v[j].y) + (v[j].z * v[j].z + v[j].w * v[j].w); }
        const float rstd = rsqrtf(wave_sum(s, lane) * (1.f / DM) + EPSV);
#pragma unroll
        for (int j = 0; j < 4; ++j) *(f32x4*)(xr + 4 * lane + 256 * j) = v[j] * rstd * *(const f32x4*)(p.final_g + 4 * lane + 256 * j);
    }
}

__global__ void __launch_bounds__(512, 2) trunk_fwd(Params p) {
    extern __shared__ __attribute__((aligned(16))) unsigned char smem[];
    cg::grid_group grid = cg::this_grid();
    volatile LAS unsigned* bst = (volatile LAS unsigned*)((LAS unsigned char*)smem + LDS_BYTES - 64);
    if (threadIdx.x < 16) bst[threadIdx.x] = 0u;
    __syncthreads();
    XcdBarrier xbar = xcd_barrier_post((unsigned*)(p.ws + WS_BAR), bst);
    for (int rep = 0; rep < REP_GS; ++rep) grid.sync();
    for (int ph = 0; ph < 38; ++ph) {
        LAS unsigned char* lds = (LAS unsigned char*)smem;
        KParams kp_ = get_params(); unsigned char* ws = kp_->ws; float* outp = kp_->out;
        bool did = true;
        if (ph == 0) { for (int rep = 0; rep < REP_P0; ++rep) { __syncthreads(); ph_prologue(smem); } }
        else if (ph == 37) { for (int rep = 0; rep < REP_FIN; ++rep) ph_final(); }
        else {
            const int li = (ph - 1) / 9, sl = (ph - 1) - li * 9, kind = li % 3;
            const int MR = li < 3 ? MT : ML;
            float* mods = (float*)(ws + WS_MODS); const float* md = mods + (size_t)li * 9 * 6144;
            bf16_t* H = (bf16_t*)(ws + WS_H); unsigned char* R = ws + WS_R; float* tab = (float*)(ws + WS_TAB);
            switch (sl) {
            case 0: for (int rep = 0; rep < REP_N; ++rep) { __syncthreads(); ph_cvt_norm1(smem, li); } break;
            case 1:
              for (int rep = 0; rep < REP_G; ++rep) {
#if EN_G1A
                if (kind == 0) { EpiQKV<0> E{R, tab}; run_gemm<3072, 1024>(lds, H, (const bf16_t*)(ws + WS_WQKV), MT, E); }
#endif
#if EN_G1B
                if (kind == 1) { EpiQKV<2> E{R, tab}; run_gemm<6144, 1024>(lds, H, (const bf16_t*)(ws + WS_WQKV), MT, E); }
#endif
#if EN_G1C
                if (kind == 2) { EpiQKV<1> E{R, tab}; run_gemm<3072, 1024>(lds, H, (const bf16_t*)(ws + WS_WQKV), MT, E); }
#endif
              }
                break;
            case 2:
#if EN_DA
                if (kind == 0) for (int rep = 0; rep < REP_DA; ++rep) ph_da_attn(smem, li);
#endif
#if EN_RP
                if (kind == 1) for (int rep = 0; rep < REP_RP; ++rep) ph_ret_p();
#endif
#if EN_NA
                if (kind == 2) for (int rep = 0; rep < REP_NA; ++rep) ph_na(smem);
#endif
                break;
            case 3:
                if (kind == 0) did = false;
#if EN_RS
                else if (kind == 1) for (int rep = 0; rep < REP_RS; ++rep) ph_ret_scan(smem);
#endif
                else did = false;
                break;
            case 4:
                if (kind == 1) { for (int rep = 0; rep < REP_RC; ++rep) ph_ret_combine(); } else did = false;
                break;
            case 5: {
#if EN_G2
              for (int rep = 0; rep < REP_G24; ++rep) {
                const float gs_ = rep == REP_G24 - 1 ? 1.f : 0.f;
                if (kind == 1) { EpiRes<32> E{outp, (float*)(ws + WS_XC), md + 2 * 1024, gs_, (float*)(R + 36 * MiB)}; run_gemm_res<2048, 4>(lds, (const bf16_t*)(R + 144 * MiB), (const bf16_t*)(ws + WS_WO), MR, E); }
                else { EpiRes<16> E{outp, (float*)(ws + WS_XC), md + 2 * 1024, gs_, (float*)(R + 36 * MiB)}; run_gemm_res<1024, 4>(lds, (const bf16_t*)(R + 108 * MiB), (const bf16_t*)(ws + WS_WO), MR, E); }
              }
#endif
                break; }
            case 6: for (int rep = 0; rep < REP_N; ++rep) ph_norm2(li); break;
            case 7: {
#if EN_G3
                EpiSwiglu E{(bf16_t*)R}; for (int rep = 0; rep < REP_G; ++rep) run_gemm<5632, 1024>(lds, H, (const bf16_t*)(ws + WS_WF1), MR, E);
#endif
                break; }
            default: {
#if EN_G4
                for (int rep = 0; rep < REP_G24; ++rep) { EpiRes<44> E{outp, (float*)(ws + WS_XC), md + 5 * 1024, rep == REP_G24 - 1 ? 1.f : 0.f, (float*)(R + 108 * MiB)}; run_gemm_res<2816, 4>(lds, (const bf16_t*)R, (const bf16_t*)(ws + WS_WF2), MR, E); }
#endif
                break; }
            }
        }
        if (did) for (int rep = 0; rep < REP_SYNC; ++rep) xcd_barrier(xbar);
    }
}

extern "C" void kernel_launch(void* const* d_in, const int* in_sizes, int n_in, void* d_out, int out_size, void* d_ws, size_t ws_size, hipStream_t stream) {
    static int grid_blocks = 0;
    if (!grid_blocks) {
        int dev = 0, cus = 0, per_cu = 0;
        (void)hipGetDevice(&dev);
        (void)hipDeviceGetAttribute(&cus, hipDeviceAttributeMultiprocessorCount, dev);
        (void)hipFuncSetAttribute((const void*)trunk_fwd, hipFuncAttributeMaxDynamicSharedMemorySize, LDS_BYTES);
        (void)hipOccupancyMaxActiveBlocksPerMultiprocessor(&per_cu, (const void*)trunk_fwd, 512, LDS_BYTES);
        grid_blocks = cus > 0 ? cus : 256;
        fprintf(stderr, "kernel_launch: cus=%d per_cu=%d ws=%zu n_in=%d\n", cus, per_cu, ws_size, n_in);
        if (ws_size < WS_NEED || n_in != 20) { fprintf(stderr, "kernel_launch: workspace too small or wrong input count\n"); grid_blocks = -1; }
    }
    if (grid_blocks < 0) return;
    (void)hipMemsetAsync((unsigned char*)d_ws + WS_BAR, 0, 16384, stream);
    Params p{};
    const float** pp = (const float**)&p;
    for (int i = 0; i < 20; ++i) pp[i] = (const float*)d_in[i];
    p.out = (float*)d_out; p.ws = (unsigned char*)d_ws;
    void* args[] = {&p};
    hipError_t e = hipLaunchCooperativeKernel((const void*)trunk_fwd, dim3(grid_blocks), dim3(512), args, LDS_BYTES, stream);
    if (e != hipSuccess) fprintf(stderr, "cooperative launch failed: %s\n", hipGetErrorString(e));
}
```
